# Optimizing an MI355X kernel written in HIP

```python
import math
import jax, jax.numpy as jnp
from jax import lax
import numpy as np

D_MODEL = 1024
BATCH = 4
SEQ = 8192
DEPTH = 4

CHUNK = 64
Q_BLOCK = 128
HEAD_DIM = 64
FOX_HEADS = 6
SB_HEADS = 6
FOX_WIDTH = FOX_HEADS * HEAD_DIM
SB_WIDTH = SB_HEADS * HEAD_DIM
MIX_WIDTH = D_MODEL
SSM_WIDTH = MIX_WIDTH - FOX_WIDTH - SB_WIDTH
SSM_GROUP = 16
SSM_GROUPS = SSM_WIDTH // SSM_GROUP
SSM_STATE = 64
D_FF = 3584
N_EXPERTS = 8
TOP_K = 2
N_DENSE_LAYERS = (DEPTH + 1) // 2
N_MOE_LAYERS = DEPTH // 2
EPS = 1e-6

PROJ_SIZES = (
    FOX_WIDTH, FOX_WIDTH, FOX_WIDTH, FOX_HEADS,
    SB_WIDTH, SB_WIDTH, SB_WIDTH,
    SSM_WIDTH,
)
PROJ_WIDTH = sum(PROJ_SIZES)
PROJ_SPLITS = [int(v) for v in np.cumsum(PROJ_SIZES)[:-1]]

kernel_name = "hybrid_fox_stickbreak_s5_moe_trunk"


def rms_norm(x, gain):
    xf = x.astype(jnp.float32)
    y = xf * lax.rsqrt(jnp.mean(xf * xf, axis=-1, keepdims=True) + EPS)
    return (y * gain.astype(jnp.float32)).astype(x.dtype)


def head_rms(t, gain=None):
    tf = t.astype(jnp.float32)
    y = tf * lax.rsqrt(jnp.mean(tf * tf, axis=-1, keepdims=True) + EPS)
    if gain is not None:
        y = y * gain.astype(jnp.float32)
    return y.astype(t.dtype)


def group_rms(y, group):
    b, s, w = y.shape
    return head_rms(y.reshape(b, s, w // group, group)).reshape(b, s, w)


def to_query_blocks(t):
    b, h, s = t.shape[:3]
    t = t.reshape((b, h, s // Q_BLOCK, Q_BLOCK) + t.shape[3:])
    return jnp.moveaxis(t, 2, 0)


def from_query_blocks(o):
    nb, b, h, q, d = o.shape
    return o.transpose(1, 0, 3, 2, 4).reshape(b, nb * q, h * d)


def fox_attention(q, k, v, log_f, q_gain, k_gain):
    s_len = q.shape[1]
    scale = HEAD_DIM ** -0.5
    q = head_rms(q, q_gain)
    k = head_rms(k, k_gain)
    c = jnp.cumsum(log_f, axis=1).transpose(0, 2, 1)
    qh = q.transpose(0, 2, 1, 3)
    kh = k.transpose(0, 2, 1, 3)
    vh = v.transpose(0, 2, 1, 3)
    key_pos = jnp.arange(s_len)
    starts = jnp.arange(s_len // Q_BLOCK) * Q_BLOCK

    def block(args):
        qb, cb, start = args
        qpos = start + jnp.arange(Q_BLOCK)
        logits = jnp.einsum('bhqd,bhkd->bhqk', qb, kh,
                            preferred_element_type=jnp.float32) * scale
        logits = logits + cb[..., None] - c[:, :, None, :]
        mask = key_pos[None, :] <= qpos[:, None]
        p = jax.nn.softmax(jnp.where(mask, logits, -jnp.inf), axis=-1)
        return jnp.einsum('bhqk,bhkd->bhqd', p.astype(vh.dtype), vh)

    out = lax.map(block, (to_query_blocks(qh), to_query_blocks(c), starts))
    return from_query_blocks(out)


def stick_breaking_attention(q, k, v):
    s_len = q.shape[1]
    scale = HEAD_DIM ** -0.5
    qh = q.transpose(0, 2, 1, 3)
    kh = k.transpose(0, 2, 1, 3)
    vh = v.transpose(0, 2, 1, 3)
    key_pos = jnp.arange(s_len)
    starts = jnp.arange(s_len // Q_BLOCK) * Q_BLOCK

    def block(args):
        qb, start = args
        qpos = start + jnp.arange(Q_BLOCK)
        z = jnp.einsum('bhqd,bhkd->bhqk', qb, kh,
                       preferred_element_type=jnp.float32) * scale
        mask = key_pos[None, :] < qpos[:, None]
        log_not = jnp.where(mask, jax.nn.log_sigmoid(-z), 0.0)
        later = lax.cumsum(log_not, axis=3, reverse=True) - log_not
        a = jnp.where(mask, jnp.exp(jax.nn.log_sigmoid(z) + later), 0.0)
        return jnp.einsum('bhqk,bhkd->bhqd', a.astype(vh.dtype), vh)

    out = lax.map(block, (to_query_blocks(qh), starts))
    return from_query_blocks(out)


def _complex_affine_combine(e1, e2):
    ar1, ai1, br1, bi1 = e1
    ar2, ai2, br2, bi2 = e2
    ar = ar2 * ar1 - ai2 * ai1
    ai = ar2 * ai1 + ai2 * ar1
    br = ar2 * br1 - ai2 * bi1 + br2
    bi = ar2 * bi1 + ai2 * br1 + bi2
    return (ar, ai, br, bi)


def s5_mixer(u, a_re, a_im, log_dt, b_re, b_im, c_re, c_im, d_skip, w_glu, b_glu):
    f32 = jnp.float32
    bsz, s_len, _ = u.shape
    uf = u.astype(f32)
    ug = uf.reshape(bsz, s_len, SSM_GROUPS, SSM_GROUP)
    a_re = a_re.astype(f32); a_im = a_im.astype(f32)
    dt = jnp.exp(log_dt.astype(f32))[:, None]
    mag = jnp.exp(dt * a_re)
    ang = dt * a_im
    abar_re = mag * jnp.cos(ang)
    abar_im = mag * jnp.sin(ang)
    num_re = abar_re - 1.0
    num_im = abar_im
    den = a_re * a_re + a_im * a_im
    coef_re = (num_re * a_re + num_im * a_im) / den
    coef_im = (num_im * a_re - num_re * a_im) / den
    b_re = b_re.astype(f32); b_im = b_im.astype(f32)
    bbar_re = coef_re[..., None] * b_re - coef_im[..., None] * b_im
    bbar_im = coef_re[..., None] * b_im + coef_im[..., None] * b_re
    bu_re = jnp.einsum('gnc,bsgc->bsgn', bbar_re, ug)
    bu_im = jnp.einsum('gnc,bsgc->bsgn', bbar_im, ug)
    ar = jnp.broadcast_to(abar_re, bu_re.shape)
    ai = jnp.broadcast_to(abar_im, bu_re.shape)
    _, _, h_re, h_im = lax.associative_scan(
        _complex_affine_combine, (ar, ai, bu_re, bu_im), axis=1)
    y = (jnp.einsum('gcn,bsgn->bsgc', c_re.astype(f32), h_re)
         - jnp.einsum('gcn,bsgn->bsgc', c_im.astype(f32), h_im))
    y = y.reshape(bsz, s_len, SSM_WIDTH) + d_skip.astype(f32) * uf
    g = jax.nn.gelu(y)
    g = g * jax.nn.sigmoid(g @ w_glu.astype(f32) + b_glu.astype(f32))
    return g.astype(u.dtype)


def swiglu(h, w_gate, w_up, w_down):
    return (jax.nn.silu(h @ w_gate) * (h @ w_up)) @ w_down


def moe_swiglu(h, w_router, w_gate, w_up, w_down):
    shape = h.shape
    hf = h.reshape(-1, shape[-1])
    logits = (hf @ w_router).astype(jnp.float32)
    top_val, top_idx = lax.top_k(logits, TOP_K)
    top_w = jax.nn.softmax(top_val, axis=-1)
    gates = jnp.sum(jax.nn.one_hot(top_idx, N_EXPERTS, dtype=jnp.float32)
                    * top_w[..., None], axis=1)
    out = jnp.zeros_like(hf)
    for e in range(N_EXPERTS):
        y = swiglu(hf, w_gate[e], w_up[e], w_down[e])
        out = out + gates[:, e:e + 1].astype(hf.dtype) * y
    return out.reshape(shape)


def setup_inputs(seed: int = 0) -> dict:
    key = jax.random.key(seed)
    ks = jax.random.split(key, 32)
    f32 = jnp.float32

    def nrm(k, shape, scale):
        return jax.random.normal(k, shape, f32) * scale

    G, N = SSM_GROUPS, SSM_STATE
    n_idx = jnp.arange(N, dtype=f32)
    return {
        "x": nrm(ks[0], (BATCH, SEQ, D_MODEL), 1.0),
        "attn_norm": 1.0 + nrm(ks[1], (DEPTH, D_MODEL), 0.02),
        "ffn_norm": 1.0 + nrm(ks[2], (DEPTH, D_MODEL), 0.02),
        "w_in": nrm(ks[3], (DEPTH, D_MODEL, PROJ_WIDTH), D_MODEL ** -0.5),
        "b_forget": jax.random.uniform(ks[4], (DEPTH, FOX_HEADS), f32, 1.0, 5.0),
        "fox_q_norm": 1.0 + nrm(ks[5], (DEPTH, HEAD_DIM), 0.02),
        "fox_k_norm": 1.0 + nrm(ks[6], (DEPTH, HEAD_DIM), 0.02),
        "ssm_a_re": -0.5 + nrm(ks[7], (DEPTH, G, N), 0.01),
        "ssm_a_im": jnp.pi * n_idx + nrm(ks[8], (DEPTH, G, N), 0.01),
        "ssm_log_dt": jax.random.uniform(ks[9], (DEPTH, G), f32,
                                         math.log(1e-3), math.log(1e-1)),
        "ssm_b_re": nrm(ks[10], (DEPTH, G, N, SSM_GROUP), (2 * SSM_GROUP) ** -0.5),
        "ssm_b_im": nrm(ks[11], (DEPTH, G, N, SSM_GROUP), (2 * SSM_GROUP) ** -0.5),
        "ssm_c_re": nrm(ks[12], (DEPTH, G, SSM_GROUP, N), N ** -0.5),
        "ssm_c_im": nrm(ks[13], (DEPTH, G, SSM_GROUP, N), N ** -0.5),
        "ssm_d": nrm(ks[14], (DEPTH, SSM_WIDTH), 1.0),
        "ssm_w_glu": nrm(ks[15], (DEPTH, SSM_WIDTH, SSM_WIDTH), SSM_WIDTH ** -0.5),
        "ssm_b_glu": nrm(ks[16], (DEPTH, SSM_WIDTH), 0.02),
        "out_norm": 1.0 + nrm(ks[17], (DEPTH, MIX_WIDTH), 0.02),
        "w_out": nrm(ks[18], (DEPTH, MIX_WIDTH, D_MODEL), MIX_WIDTH ** -0.5),
        "dense_w_gate": nrm(ks[19], (N_DENSE_LAYERS, D_MODEL, D_FF), D_MODEL ** -0.5),
        "dense_w_up": nrm(ks[20], (N_DENSE_LAYERS, D_MODEL, D_FF), D_MODEL ** -0.5),
        "dense_w_down": nrm(ks[21], (N_DENSE_LAYERS, D_FF, D_MODEL), D_FF ** -0.5),
        "moe_w_router": nrm(ks[22], (N_MOE_LAYERS, D_MODEL, N_EXPERTS), D_MODEL ** -0.5),
        "moe_w_gate": nrm(ks[23], (N_MOE_LAYERS, N_EXPERTS, D_MODEL, D_FF), D_MODEL ** -0.5),
        "moe_w_up": nrm(ks[24], (N_MOE_LAYERS, N_EXPERTS, D_MODEL, D_FF), D_MODEL ** -0.5),
        "moe_w_down": nrm(ks[25], (N_MOE_LAYERS, N_EXPERTS, D_FF, D_MODEL), D_FF ** -0.5),
    }


def reference(x, attn_norm, ffn_norm, w_in, b_forget, fox_q_norm, fox_k_norm,
              ssm_a_re, ssm_a_im, ssm_log_dt, ssm_b_re, ssm_b_im, ssm_c_re,
              ssm_c_im, ssm_d, ssm_w_glu, ssm_b_glu, out_norm, w_out,
              dense_w_gate, dense_w_up, dense_w_down, moe_w_router,
              moe_w_gate, moe_w_up, moe_w_down):
    bsz, s_len, _ = x.shape
    for i in range(DEPTH):
        h = rms_norm(x, attn_norm[i])
        proj = h @ w_in[i]
        fq, fk, fv, fgl, sq, sk, sv, su = jnp.split(proj, PROJ_SPLITS, axis=-1)
        log_f = jax.nn.log_sigmoid((fgl + b_forget[i]).astype(jnp.float32))
        heads_f = (bsz, s_len, FOX_HEADS, HEAD_DIM)
        heads_s = (bsz, s_len, SB_HEADS, HEAD_DIM)
        y_fox = fox_attention(fq.reshape(heads_f), fk.reshape(heads_f),
                              fv.reshape(heads_f), log_f,
                              fox_q_norm[i], fox_k_norm[i])
        y_sb = stick_breaking_attention(sq.reshape(heads_s), sk.reshape(heads_s),
                                        sv.reshape(heads_s))
        y_ssm = s5_mixer(su, ssm_a_re[i], ssm_a_im[i], ssm_log_dt[i],
                         ssm_b_re[i], ssm_b_im[i], ssm_c_re[i], ssm_c_im[i],
                         ssm_d[i], ssm_w_glu[i], ssm_b_glu[i])
        mix = jnp.concatenate([group_rms(y_fox, HEAD_DIM),
                               group_rms(y_sb, HEAD_DIM),
                               group_rms(y_ssm, SSM_GROUP)], axis=-1)
        mix = mix * out_norm[i].astype(mix.dtype)
        x = x + mix @ w_out[i]
        h = rms_norm(x, ffn_norm[i])
        j = i // 2
        if i % 2 == 0:
            x = x + swiglu(h, dense_w_gate[j], dense_w_up[j], dense_w_down[j])
        else:
            x = x + moe_swiglu(h, moe_w_router[j], moe_w_gate[j],
                               moe_w_up[j], moe_w_down[j])
    return x
```

```cpp
#include <hip/hip_runtime.h>
#include <cstdio>
#include <cstdint>
#include <cmath>

#define GAS __attribute__((address_space(1)))
#define LAS __attribute__((address_space(3)))
typedef unsigned short bf16;
typedef short bf16x8 __attribute__((ext_vector_type(8)));
typedef float f32x4 __attribute__((ext_vector_type(4)));
typedef float f32x2 __attribute__((ext_vector_type(2)));
typedef float f32x16 __attribute__((ext_vector_type(16)));
typedef unsigned u32x4 __attribute__((ext_vector_type(4)));
typedef unsigned u32x2 __attribute__((ext_vector_type(2)));
typedef GAS unsigned gu32;

constexpr int NB = 4, SEQ = 8192, DM = 1024, NL = 4;
constexpr int T = NB * SEQ;
constexpr int HD = 64, NHF = 6, NHS = 6;
constexpr int PROJW = 2566;
constexpr int NQK = 1792;
constexpr int NVT = 768;
constexpr int SSMW = 256, SG = 16, NG = 16, NS = 64;
constexpr int DFF = 3584, NE = 8;
constexpr int CH = 64, NCH = SEQ / CH;
constexpr float EPS = 1e-6f;
constexpr float LOG2E = 1.4426950408889634f;
constexpr float QSCALE = 0.125f * LOG2E;
constexpr int MOE_TILES_MAX = 264, MOE_PASS_TILES = 132;

constexpr size_t MiB = 1u << 20;
constexpr size_t WS_CTL = 0, CTL_BYTES = 1 * MiB;
constexpr size_t WS_S5T = 1 * MiB;
constexpr size_t WS_WGLU = 2 * MiB;
constexpr size_t WS_LOGF = 3 * MiB;
constexpr size_t WS_C2 = 4 * MiB;
constexpr size_t WS_SEND = 5 * MiB;
constexpr size_t WS_RTE = 9 * MiB;
constexpr size_t WS_RTW = WS_RTE + 256 * 1024;
constexpr size_t WS_LRANK = WS_RTW + 256 * 1024;
constexpr size_t WS_TOKROW = WS_LRANK + 256 * 1024;
constexpr size_t WS_WGCNT = 10 * MiB;
constexpr size_t WS_MOEB = WS_WGCNT + 16384;
constexpr size_t WS_PTRS = WS_WGCNT + 32768;
constexpr size_t WS_WIN = 12 * MiB;
constexpr size_t WS_WOUT = 32 * MiB;
constexpr size_t WS_DGU = 40 * MiB;
constexpr size_t WS_DDN = 68 * MiB;
constexpr size_t WS_MGU = 82 * MiB;
constexpr size_t WS_MDN = 306 * MiB;
constexpr size_t WS_XN = 418 * MiB;
constexpr size_t WS_R1 = 482 * MiB;
constexpr size_t WS_FQ = WS_R1, WS_FK = WS_R1 + 24 * MiB, WS_SQ = WS_R1 + 48 * MiB, WS_SK = WS_R1 + 72 * MiB;
constexpr size_t WS_VT = WS_R1 + 96 * MiB;
constexpr size_t WS_SU = WS_R1 + 144 * MiB;
constexpr size_t WS_MIX = WS_R1 + 176 * MiB;
constexpr size_t WS_HID = WS_R1;
constexpr size_t WS_R2 = 722 * MiB;
constexpr size_t WS_END = 854 * MiB;
constexpr int CW_TMO = 0;
constexpr int CW_QHEAD = 64;
constexpr int CW_BAR = 4096;

constexpr int LDS_BYTES = 155648;
constexpr int LDS_CTL = 154624;
constexpr int RING_BYTES = 131072;

#define RLX_AGENT __ATOMIC_RELAXED, __HIP_MEMORY_SCOPE_AGENT
#define LDS_WAIT() asm volatile("s_waitcnt lgkmcnt(0)" ::: "memory")
__device__ __forceinline__ unsigned f2bf(float f) { unsigned u = __builtin_bit_cast(unsigned, f); return (u + 0x7fffu + ((u >> 16) & 1u)) >> 16; }
__device__ __forceinline__ unsigned pk2(float lo, float hi) { typedef __bf16 bf2 __attribute__((ext_vector_type(2))); f32x2 v = {lo, hi}; bf2 b = __builtin_convertvector(v, bf2); return __builtin_bit_cast(unsigned, b); }
__device__ __forceinline__ float bf2f(unsigned short h) { return __builtin_bit_cast(float, (unsigned)h << 16); }
__device__ __forceinline__ float wave_sum(float v) {
#pragma unroll
    for (int o = 1; o < 64; o <<= 1) v += __shfl_xor(v, o);
    return v;
}
__device__ __forceinline__ float wave_max(float v) {
#pragma unroll
    for (int o = 1; o < 64; o <<= 1) v = fmaxf(v, __shfl_xor(v, o));
    return v;
}
__device__ __forceinline__ float fexp2(float x) { return __builtin_amdgcn_exp2f(x); }
__device__ __forceinline__ float frcp(float x) { return __builtin_amdgcn_rcpf(x); }

namespace pg8 {
constexpr int BM = 256, BK = 64, HALF = 128, HTB = HALF * BK * 2, STAGE_BYTES = 8 * HTB, NXCD = 8, WGM = 8;
__host__ __device__ __forceinline__ int lds_byte(int r, int c) { const int st = (r >> 4) * 2 + (c >> 5), rr = r & 15, cc = c & 31, ob = rr * 64 + cc * 2; return st * 1024 + (ob ^ (((ob >> 9) & 1) << 5)); }
__host__ __device__ __forceinline__ void stage_rc(int b, int& R, int& C) { const int st = b / 1024, sb = b % 1024, swz = sb ^ (((sb >> 9) & 1) << 5); R = (st >> 1) * 16 + swz / 64; C = (st & 1) * 32 + (swz % 64) / 2; }
__host__ __device__ __forceinline__ int perm32(int rho) { const int n = rho >> 4, i = rho & 15; return 8 * (i >> 2) + 4 * n + (i & 3); }

struct Unit { int pm, pn, e; const char* A; const char* B; };

__device__ __forceinline__ bool tile_order(int i, int G, int c, int nM, int nN, int& pm, int& pn) {
    const int nwg = nM * nN; const long L = (long)i * G + c; if (L >= nwg) return false;
    int wgid = (int)L; { const int q = nwg / NXCD, r = nwg % NXCD, xcd = wgid % NXCD, off = wgid / NXCD; wgid = (xcd < r ? xcd * (q + 1) : r * (q + 1) + (xcd - r) * q) + off; }
    const int nig = WGM * nN, gid = wgid / nig, fm = gid * WGM, gsz = (nM - fm) < WGM ? (nM - fm) : WGM;
    pm = fm + ((wgid % nig) % gsz); pn = (wgid % nig) / gsz; return true;
}
constexpr int UNITS_OFF = 131072, UNITS_MAX = 64;
struct SchedLds {
    const LAS unsigned* list; int cnt;
    __device__ __forceinline__ bool next(int i, Unit& u) const {
        if (i >= cnt) return false;
        const u32x4 a = *(const LAS u32x4*)(list + 8 * i), b = *(const LAS u32x4*)(list + 8 * i + 4);
        u.pm = __builtin_amdgcn_readfirstlane((int)a.x); u.pn = __builtin_amdgcn_readfirstlane((int)a.y); u.e = __builtin_amdgcn_readfirstlane((int)a.z);
        const unsigned alo = __builtin_amdgcn_readfirstlane(b.x), ahi = __builtin_amdgcn_readfirstlane(b.y), blo = __builtin_amdgcn_readfirstlane(b.z), bhi = __builtin_amdgcn_readfirstlane(b.w);
        u.A = (const char*)(((unsigned long long)ahi << 32) | alo); u.B = (const char*)(((unsigned long long)bhi << 32) | blo); return true;
    }
};
__device__ __forceinline__ void put_unit(LAS unsigned* list, int i, int pm, int pn, int e, const char* A, const char* B) {
    const unsigned long long a = (unsigned long long)A, b = (unsigned long long)B;
    *(LAS u32x4*)(list + 8 * i) = (u32x4){(unsigned)pm, (unsigned)pn, (unsigned)e, 0u}; *(LAS u32x4*)(list + 8 * i + 4) = (u32x4){(unsigned)a, (unsigned)(a >> 32), (unsigned)b, (unsigned)(b >> 32)};
}
__device__ __forceinline__ SchedLds build_units_plain(LAS unsigned char* lds, int tid, int G, int c, int nM, int nN, const char* A0, const char* B0, size_t tstep) {
    LAS unsigned* list = (LAS unsigned*)(lds + UNITS_OFF);
    int pm, pn; int cnt = 0;
    if (tid < UNITS_MAX && tile_order(tid, G, c, nM, nN, pm, pn)) put_unit(list, tid, pm, pn, 0, A0 + (size_t)pm * tstep, B0 + (size_t)pn * tstep);
    { const int nwg = nM * nN; cnt = (c < nwg) ? (nwg - c + G - 1) / G : 0; }
    LDS_WAIT(); __syncthreads();
    return SchedLds{list, cnt};
}
__device__ __forceinline__ SchedLds build_units_moe(LAS unsigned char* lds, int tid, int G, int c, int nM, int nN, int tlo, const int* eb, const char* A0, const char* B0, size_t tstepA, size_t tstepB, size_t estride, bool a_local) {
    LAS unsigned* list = (LAS unsigned*)(lds + UNITS_OFF);
    int pm, pn; int cnt = 0;
    if (tid < UNITS_MAX && tile_order(tid, G, c, nM, nN, pm, pn)) {
        const int gp = tlo + pm; int e = 0;
        for (int j = 1; j < 8; ++j) e += (gp >= eb[j]) ? 1 : 0;
        put_unit(list, tid, gp, pn, e, A0 + (size_t)(a_local ? pm : gp) * tstepA, B0 + (size_t)e * estride + (size_t)pn * tstepB);
    }
    { const int nwg = nM * nN; cnt = (c < nwg) ? (nwg - c + G - 1) / G : 0; }
    LDS_WAIT(); __syncthreads();
    return SchedLds{list, cnt};
}

template <class Epi, class Sched, bool ALIGN_EPI, bool SP2>
__device__ __forceinline__ void gemm_phase(LAS unsigned char* lds, const int tid, const int K, const Sched& S, const Epi& E) {
    const int wid = __builtin_amdgcn_readfirstlane(tid >> 6), lane = tid & 63, wr = wid >> 2, wc = wid & 3, fr = lane & 15, fq = lane >> 4;
    const int nt = K / BK;
    unsigned voffA[2], voffB[2];
#pragma unroll
    for (int i = 0; i < 2; ++i) { int R, C; stage_rc(tid * 16 + i * 8192, R, C); const int Rb = Epi::PERM ? ((R & ~31) + perm32(R & 31)) : R;
        voffA[i] = (unsigned)(R * K + C) * 2u; voffB[i] = (unsigned)(Rb * K + C) * 2u; }
    const size_t kstep = (size_t)(BK * 2);
    const size_t hstep = (size_t)HALF * K * 2;
    const unsigned ldsw = (unsigned)wid * 1024u;
    const int aoff = lds_byte(wr * 64 + fr, fq * 8), boff = lds_byte(wc * 32 + fr, fq * 8);
#define PG8_SA(b, h) (((b) * 2 + (h)) * HTB)
#define PG8_SB(b, h) ((4 + (b) * 2 + (h)) * HTB)
#define PG8_STAGE(bufoff, gbase, voff) do { _Pragma("unroll") for (int _i = 0; _i < 2; ++_i) \
        __builtin_amdgcn_global_load_lds((const unsigned*)((const char*)(gbase) + (voff)[_i]), (LAS unsigned*)(lds + (bufoff) + ldsw + _i * 8192), 16, 0, 0); } while (0)
#define PG8_LDA(dst, b, h) do { _Pragma("unroll") for (int m = 0; m < 4; ++m) _Pragma("unroll") for (int k = 0; k < 2; ++k) dst[m][k] = *(const LAS bf16x8*)(lds + PG8_SA(b, h) + aoff + m * 2048 + k * 1024); } while (0)
#define PG8_LDB(dst, b, h) do { _Pragma("unroll") for (int n = 0; n < 2; ++n) _Pragma("unroll") for (int k = 0; k < 2; ++k) dst[n][k] = *(const LAS bf16x8*)(lds + PG8_SB(b, h) + boff + n * 2048 + k * 1024); } while (0)
#define PG8_MMA(ai, bj, At, Bt) do { __builtin_amdgcn_s_setprio(1); _Pragma("unroll") for (int m = 0; m < 4; ++m) _Pragma("unroll") for (int n = 0; n < 2; ++n) _Pragma("unroll") for (int k = 0; k < 2; ++k) \
        acc[ai][bj][m][n] = __builtin_amdgcn_mfma_f32_16x16x32_bf16(Bt[n][k], At[m][k], acc[ai][bj][m][n], 0, 0, 0); __builtin_amdgcn_s_setprio(0); } while (0)
#define PG8_WAIT_V(n) asm volatile("s_waitcnt vmcnt(" #n ")" ::: "memory")
#define PG8_WAIT_L(n) asm volatile("s_waitcnt lgkmcnt(" #n ")" ::: "memory")
#define PG8_BAR __builtin_amdgcn_s_barrier()
#define PG8_SCHED __builtin_amdgcn_sched_barrier(0)
    Unit cur, nxt; int ui = 0;
    if (!S.next(0, cur)) return;
    f32x4 acc[2][2][4][2];
#pragma unroll
    for (int a = 0; a < 2; ++a)
#pragma unroll
        for (int b = 0; b < 2; ++b)
#pragma unroll
            for (int m = 0; m < 4; ++m)
#pragma unroll
                for (int n = 0; n < 2; ++n) acc[a][b][m][n] = (f32x4){0.f, 0.f, 0.f, 0.f};
    bf16x8 At[4][2], B0[2][2], B1[2][2];
    const char* cA = cur.A; const char* cB = cur.B;
    if constexpr (SP2) {
        PG8_STAGE(PG8_SB(0, 0), cB, voffB); PG8_STAGE(PG8_SB(0, 1), cB + hstep, voffB); PG8_STAGE(PG8_SA(0, 0), cA, voffA); PG8_STAGE(PG8_SA(0, 1), cA + hstep, voffA);
        if (wr == 1) PG8_BAR;
        PG8_WAIT_V(2); PG8_BAR;
        PG8_STAGE(PG8_SB(1, 0), cB + kstep, voffB); PG8_STAGE(PG8_SA(1, 0), cA + kstep, voffA); PG8_STAGE(PG8_SB(1, 1), cB + hstep + kstep, voffB);
        PG8_WAIT_V(6); PG8_BAR;
    } else {
        PG8_STAGE(PG8_SB(0, 0), cB, voffB); PG8_STAGE(PG8_SA(0, 0), cA, voffA); PG8_STAGE(PG8_SB(0, 1), cB + hstep, voffB); PG8_STAGE(PG8_SA(0, 1), cA + hstep, voffA);
        if (wr == 1) PG8_BAR;
        PG8_WAIT_V(4); PG8_BAR;
        PG8_STAGE(PG8_SB(1, 0), cB + kstep, voffB); PG8_STAGE(PG8_SA(1, 0), cA + kstep, voffA); PG8_STAGE(PG8_SB(1, 1), cB + hstep + kstep, voffB);
        PG8_WAIT_V(6); PG8_BAR;
    }
    for (;;) {
        const bool has_next = S.next(ui + 1, nxt);
        const char* nA = has_next ? nxt.A : cA; const char* nB = has_next ? nxt.B : cB;
        for (int t = 0; t < nt; t += 2) {
            const bool last = (t == nt - 2);
            const char* a1 = cA + (size_t)(t + 1) * kstep;
            const char* a2 = last ? nA : cA + (size_t)(t + 2) * kstep; const char* b2 = last ? nB : cB + (size_t)(t + 2) * kstep;
            const char* a3 = a2 + kstep; const char* b3 = b2 + kstep;
            if constexpr (SP2) {
            PG8_LDB(B0, 0, 0); PG8_LDB(B1, 0, 1); PG8_SCHED; PG8_LDA(At, 0, 0); PG8_STAGE(PG8_SA(1, 1), a1 + hstep, voffA);
            PG8_WAIT_V(8); PG8_WAIT_L(0); PG8_BAR; PG8_MMA(0, 0, At, B0); PG8_MMA(0, 1, At, B1); PG8_BAR; PG8_SCHED;
            PG8_LDA(At, 0, 1); PG8_STAGE(PG8_SB(0, 0), b2, voffB); PG8_STAGE(PG8_SB(0, 1), b2 + hstep, voffB); PG8_STAGE(PG8_SA(0, 0), a2, voffA);
            PG8_WAIT_V(8); PG8_WAIT_L(0); PG8_BAR; PG8_MMA(1, 0, At, B0); PG8_MMA(1, 1, At, B1); PG8_BAR; PG8_SCHED;
            PG8_LDB(B0, 1, 0); PG8_LDB(B1, 1, 1); PG8_SCHED; PG8_LDA(At, 1, 0); PG8_STAGE(PG8_SA(0, 1), a2 + hstep, voffA);
            PG8_WAIT_V(8); PG8_WAIT_L(0); PG8_BAR; PG8_MMA(0, 0, At, B0); PG8_MMA(0, 1, At, B1); PG8_BAR; PG8_SCHED;
            PG8_LDA(At, 1, 1); PG8_STAGE(PG8_SB(1, 0), b3, voffB); PG8_STAGE(PG8_SB(1, 1), b3 + hstep, voffB); PG8_STAGE(PG8_SA(1, 0), a3, voffA);
            PG8_WAIT_V(8); PG8_WAIT_L(0); PG8_BAR; PG8_MMA(1, 0, At, B0); PG8_MMA(1, 1, At, B1); PG8_BAR; PG8_SCHED;
            } else {
            PG8_LDB(B0, 0, 0); PG8_SCHED; PG8_LDA(At, 0, 0); PG8_STAGE(PG8_SA(1, 1), a1 + hstep, voffA);
            PG8_WAIT_L(8); PG8_BAR; PG8_WAIT_L(0); PG8_MMA(0, 0, At, B0); PG8_BAR; PG8_SCHED;
            PG8_LDB(B1, 0, 1); PG8_STAGE(PG8_SB(0, 0), b2, voffB);
            PG8_BAR; PG8_WAIT_L(0); PG8_MMA(0, 1, At, B1); PG8_BAR;
            PG8_LDA(At, 0, 1); PG8_STAGE(PG8_SA(0, 0), a2, voffA);
            PG8_BAR; PG8_WAIT_L(0); PG8_MMA(1, 0, At, B0); PG8_BAR; PG8_SCHED;
            PG8_STAGE(PG8_SB(0, 1), b2 + hstep, voffB);
            PG8_WAIT_V(6); PG8_BAR; PG8_MMA(1, 1, At, B1); PG8_BAR;
            PG8_LDB(B0, 1, 0); PG8_SCHED; PG8_LDA(At, 1, 0); PG8_STAGE(PG8_SA(0, 1), a2 + hstep, voffA);
            PG8_WAIT_L(8); PG8_BAR; PG8_WAIT_L(0); PG8_MMA(0, 0, At, B0); PG8_BAR; PG8_SCHED;
            PG8_LDB(B1, 1, 1); PG8_STAGE(PG8_SB(1, 0), b3, voffB);
            PG8_BAR; PG8_WAIT_L(0); PG8_MMA(0, 1, At, B1); PG8_BAR;
            PG8_LDA(At, 1, 1); PG8_STAGE(PG8_SA(1, 0), a3, voffA);
            PG8_BAR; PG8_WAIT_L(0); PG8_MMA(1, 0, At, B0); PG8_BAR; PG8_SCHED;
            PG8_STAGE(PG8_SB(1, 1), b3 + hstep, voffB);
            PG8_WAIT_V(6); PG8_BAR; PG8_MMA(1, 1, At, B1); PG8_BAR;
            }
        }
        if constexpr (ALIGN_EPI) { if (wr == 0) PG8_BAR; }
        E(acc, cur, wr, wc, fr, fq);
        if (!has_next) break;
#pragma unroll
        for (int a = 0; a < 2; ++a)
#pragma unroll
            for (int b = 0; b < 2; ++b)
#pragma unroll
                for (int m = 0; m < 4; ++m)
#pragma unroll
                    for (int n = 0; n < 2; ++n) acc[a][b][m][n] = (f32x4){0.f, 0.f, 0.f, 0.f};
        cur = nxt; cA = nA; cB = nB; ++ui;
        if constexpr (ALIGN_EPI) { if (wr == 1) PG8_BAR; }
    }
    PG8_WAIT_V(0);
    if constexpr (!ALIGN_EPI) { if (wr == 0) PG8_BAR; }
    PG8_BAR;
#undef PG8_SA
#undef PG8_SB
#undef PG8_STAGE
#undef PG8_LDA
#undef PG8_LDB
#undef PG8_MMA
#undef PG8_WAIT_V
#undef PG8_WAIT_L
#undef PG8_BAR
#undef PG8_SCHED
}

typedef f32x4 Acc[2][2][4][2];

struct EpiProj {
    static constexpr bool PERM = true;
    bf16 *FQ, *FK, *SQ, *SK; float* SU; const float* qg; const float* kg;
    __device__ __forceinline__ void operator()(const Acc& acc, const Unit& u, int wr, int wc, int fr, int fq) const {
        const int g = 4 * u.pn + wc; const int row0 = u.pm * BM + wr * 64 + fr;
        if (g < 12) {
            const float* gp = (g < 6 ? qg : kg); const float sc = (g < 6) ? QSCALE : 1.f;
            bf16* dst = (g < 6 ? FQ + g * 64 : FK + (g - 6) * 64);
            f32x4 gv[2][2];
#pragma unroll
            for (int bj = 0; bj < 2; ++bj)
#pragma unroll
                for (int n = 0; n < 2; ++n) gv[bj][n] = *(const f32x4*)(gp + 32 * bj + 8 * fq + 4 * n) * sc;
#pragma unroll
            for (int ai = 0; ai < 2; ++ai)
#pragma unroll
                for (int m = 0; m < 4; ++m) {
                    float ss = 0.f;
#pragma unroll
                    for (int bj = 0; bj < 2; ++bj)
#pragma unroll
                        for (int n = 0; n < 2; ++n) { const f32x4 v = acc[ai][bj][m][n]; ss += (v[0] * v[0] + v[1] * v[1]) + (v[2] * v[2] + v[3] * v[3]); }
                    ss += __shfl_xor(ss, 16); ss += __shfl_xor(ss, 32);
                    const float r = __builtin_amdgcn_rsqf(ss * (1.f / 64.f) + EPS);
                    bf16* rowp = dst + (size_t)(row0 + ai * HALF + m * 16) * 384 + 8 * fq;
#pragma unroll
                    for (int bj = 0; bj < 2; ++bj) { const f32x4 v0 = acc[ai][bj][m][0] * r * gv[bj][0], v1 = acc[ai][bj][m][1] * r * gv[bj][1];
                        u32x4 w; w.x = pk2(v0[0], v0[1]); w.y = pk2(v0[2], v0[3]); w.z = pk2(v1[0], v1[1]); w.w = pk2(v1[2], v1[3]);
                        *(u32x4*)(rowp + 32 * bj) = w; }
                }
        } else if (g < 24) {
            const float sc = (g < 18) ? QSCALE : 1.f;
            bf16* dst = (g < 18 ? SQ + (g - 12) * 64 : SK + (g - 18) * 64);
#pragma unroll
            for (int ai = 0; ai < 2; ++ai)
#pragma unroll
                for (int m = 0; m < 4; ++m) { bf16* rowp = dst + (size_t)(row0 + ai * HALF + m * 16) * 384 + 8 * fq;
#pragma unroll
                    for (int bj = 0; bj < 2; ++bj) { const f32x4 v0 = acc[ai][bj][m][0] * sc, v1 = acc[ai][bj][m][1] * sc;
                        u32x4 w; w.x = pk2(v0[0], v0[1]); w.y = pk2(v0[2], v0[3]); w.z = pk2(v1[0], v1[1]); w.w = pk2(v1[2], v1[3]);
                        *(u32x4*)(rowp + 32 * bj) = w; } }
        } else {
            float* dst = SU + (g - 24) * 64;
#pragma unroll
            for (int ai = 0; ai < 2; ++ai)
#pragma unroll
                for (int m = 0; m < 4; ++m) { float* rowp = dst + (size_t)(row0 + ai * HALF + m * 16) * SSMW + 8 * fq;
#pragma unroll
                    for (int bj = 0; bj < 2; ++bj) { *(f32x4*)(rowp + 32 * bj) = acc[ai][bj][m][0]; *(f32x4*)(rowp + 32 * bj + 4) = acc[ai][bj][m][1]; } }
        }
    }
};
struct EpiStoreBf16 {
    static constexpr bool PERM = true;
    bf16* O; int ldc; int pm_off;
    __device__ __forceinline__ void operator()(const Acc& acc, const Unit& u, int wr, int wc, int fr, int fq) const {
        const int row0 = (u.pm - pm_off) * BM + wr * 64 + fr, col0 = u.pn * BM + wc * 32 + 8 * fq;
#pragma unroll
        for (int ai = 0; ai < 2; ++ai)
#pragma unroll
            for (int m = 0; m < 4; ++m) { bf16* rowp = O + (size_t)(row0 + ai * HALF + m * 16) * ldc + col0;
#pragma unroll
                for (int bj = 0; bj < 2; ++bj) { const f32x4 v0 = acc[ai][bj][m][0], v1 = acc[ai][bj][m][1];
                    u32x4 w; w.x = pk2(v0[0], v0[1]); w.y = pk2(v0[2], v0[3]); w.z = pk2(v1[0], v1[1]); w.w = pk2(v1[2], v1[3]);
                    *(u32x4*)(rowp + bj * HALF) = w; } }
    }
};
struct EpiResid {
    static constexpr bool PERM = false;
    const float* base; float* out;
    __device__ __forceinline__ void operator()(const Acc& acc, const Unit& u, int wr, int wc, int fr, int fq) const {
        const int row0 = u.pm * BM + wr * 64 + fr, col0 = u.pn * BM + wc * 32 + 4 * fq;
#pragma unroll
        for (int ai = 0; ai < 2; ++ai)
#pragma unroll
            for (int m = 0; m < 4; ++m) { const size_t off = (size_t)(row0 + ai * HALF + m * 16) * DM + col0;
#pragma unroll
                for (int bj = 0; bj < 2; ++bj)
#pragma unroll
                    for (int n = 0; n < 2; ++n) { const f32x4 b = *(const f32x4*)(base + off + bj * HALF + n * 16); *(f32x4*)(out + off + bj * HALF + n * 16) = b + acc[ai][bj][m][n]; } }
    }
};
struct EpiSwiglu {
    static constexpr bool PERM = true;
    bf16* Hd; int pm_off;
    __device__ __forceinline__ void operator()(const Acc& acc, const Unit& u, int wr, int wc, int fr, int fq) const {
        const int row0 = (u.pm - pm_off) * BM + wr * 64 + fr, col0 = u.pn * HALF + wc * 32 + 8 * fq;
#pragma unroll
        for (int ai = 0; ai < 2; ++ai)
#pragma unroll
            for (int m = 0; m < 4; ++m) { bf16* rowp = Hd + (size_t)(row0 + ai * HALF + m * 16) * DFF + col0;
                float h[8];
#pragma unroll
                for (int n = 0; n < 2; ++n)
#pragma unroll
                    for (int i = 0; i < 4; ++i) { const float a = acc[ai][0][m][n][i], b = acc[ai][1][m][n][i]; h[4 * n + i] = a * frcp(1.f + fexp2(-a * LOG2E)) * b; }
                u32x4 w; w.x = pk2(h[0], h[1]); w.y = pk2(h[2], h[3]); w.z = pk2(h[4], h[5]); w.w = pk2(h[6], h[7]);
                *(u32x4*)rowp = w; }
    }
};
}

#define XB_TMO      128
#define XB_XCNT(j)  (256  + 64 * (j))
#define XB_XSUB(j)  (1280 + 64 * (j))
#define XB_XGEN(j)  (2304 + 64 * (j))
#define XB_TOP      3328
#define XB_TOPGEN   3392
#define XCD_BAR_WORDS 3456
#define XB_SPIN_CAP (1u << 18)
__device__ __forceinline__ unsigned xb_ld(unsigned* p)              { return __hip_atomic_load(p, __ATOMIC_RELAXED, __HIP_MEMORY_SCOPE_AGENT); }
__device__ __forceinline__ unsigned xb_add(unsigned* p, unsigned v) { return __hip_atomic_fetch_add(p, v, __ATOMIC_RELAXED, __HIP_MEMORY_SCOPE_AGENT); }
__device__ __forceinline__ unsigned xb_xcc_id() { return (unsigned)__builtin_amdgcn_s_getreg((3 << 11) | 20) & 0xFu; }
#define XB_SPIN(cond, bar) do { unsigned _sp = 0; while (cond) { __builtin_amdgcn_s_sleep(1); \
    if ((++_sp & 255u) == 0u) { if (xb_ld(&(bar)[XB_TMO])) break; if (_sp > XB_SPIN_CAP) { atomicAdd(&(bar)[XB_TMO], 1u); break; } } } } while (0)
struct XcdBarrier { unsigned* bar; unsigned x; volatile LAS unsigned* st; };
__device__ __forceinline__ XcdBarrier xcd_barrier_post(unsigned* bar, volatile LAS unsigned* st) {
    XcdBarrier b; b.bar = bar; b.x = xb_xcc_id(); b.st = st;
    if (threadIdx.x == 0) (void)xb_add(&bar[XB_XCNT(b.x)], 1u);
    return b;
}
__device__ __forceinline__ void xcd_barrier_complete(unsigned* bar, unsigned x, unsigned& nloc, unsigned& nx) {
    const unsigned G = gridDim.x * gridDim.y * gridDim.z;
    unsigned sum, cnt, mine, sp = 0u;
    for (;;) {
        sum = 0u; cnt = 0u; mine = 0u;
#pragma unroll
        for (unsigned j = 0; j < 16; ++j) { const unsigned c = xb_ld(&bar[XB_XCNT(j)]); sum += c; cnt += (c > 0u) ? 1u : 0u; mine = (j == x) ? c : mine; }
        if (sum == G) break;
        __builtin_amdgcn_s_sleep(1);
        if ((++sp & 255u) == 0u) { if (xb_ld(&bar[XB_TMO])) break; if (sp > XB_SPIN_CAP) { atomicAdd(&bar[XB_TMO], 1u); break; } }
    }
    nloc = mine > 0u ? mine : 1u; nx = cnt > 0u ? cnt : 1u;
}
__device__ __forceinline__ void xcd_barrier(const XcdBarrier& b) {
    asm volatile("s_waitcnt vmcnt(0)" ::: "memory");
    __syncthreads();
    if (threadIdx.x == 0) {
        unsigned* bar = b.bar;
        __builtin_amdgcn_s_waitcnt(0);
        unsigned nloc = b.st[0], nx = b.st[1];
        if (nloc == 0u) { xcd_barrier_complete(bar, b.x, nloc, nx); b.st[0] = nloc; b.st[1] = nx; }
        const unsigned old = xb_add(&bar[XB_XSUB(b.x)], 1u);
        const unsigned gen = old / nloc;
        if (old + 1u == (gen + 1u) * nloc) {
            __builtin_amdgcn_fence(__ATOMIC_RELEASE, "agent");
            asm volatile("s_waitcnt vmcnt(0)" ::: "memory");
            const unsigned og = xb_add(&bar[XB_TOP], 1u);
            const unsigned tg = og / nx;
            if (og + 1u == (tg + 1u) * nx) xb_add(&bar[XB_TOPGEN], 1u);
            else XB_SPIN(xb_ld(&bar[XB_TOPGEN]) == tg, bar);
            __builtin_amdgcn_fence(__ATOMIC_ACQUIRE, "agent");
            xb_add(&bar[XB_XGEN(b.x)], 1u);
            asm volatile("s_waitcnt vmcnt(0)" ::: "memory");
        } else {
            XB_SPIN(xb_ld(&bar[XB_XGEN(b.x)]) == gen, bar);
            __builtin_amdgcn_fence(__ATOMIC_ACQUIRE, "agent");
            asm volatile("s_waitcnt vmcnt(0)" ::: "memory");
        }
    }
    __syncthreads();
}

struct Args { const float* in[26]; float* out; unsigned char* ws; int ph_lo, ph_hi, li, pad; };
struct Frame {
    LAS unsigned char* lds;
    gu32* ctl;
    int tid, lane, wave, vcu, G;
    const float* const* in;
    unsigned char* ws; float* out;
};
#define IN_X 0
#define IN_ATTN_NORM 1
#define IN_FFN_NORM 2
#define IN_W_IN 3
#define IN_B_FORGET 4
#define IN_FQN 5
#define IN_FKN 6
#define IN_A_RE 7
#define IN_A_IM 8
#define IN_LOG_DT 9
#define IN_B_RE 10
#define IN_B_IM 11
#define IN_C_RE 12
#define IN_C_IM 13
#define IN_SSM_D 14
#define IN_W_GLU 15
#define IN_B_GLU 16
#define IN_OUT_NORM 17
#define IN_W_OUT 18
#define IN_DGATE 19
#define IN_DUP 20
#define IN_DDOWN 21
#define IN_ROUTER 22
#define IN_MGATE 23
#define IN_MUP 24
#define IN_MDOWN 25

__device__ __forceinline__ int map_row(int kind, int n) {
    if (kind == 0) return n;
    if (kind == 2) return 256 * (n >> 7) + (n & 127);
    if (kind == 3) return 256 * (n >> 7) + 128 + (n & 127);
    int j;
    if (n < 768) j = n;
    else if (n < 1152) return NQK + (n - 768);
    else if (n < 1158) return -1;
    else if (n < 1542) j = 768 + (n - 1158);
    else if (n < 1926) j = 1152 + (n - 1542);
    else if (n < 2310) return NQK + 384 + (n - 1926);
    else j = 1536 + (n - 2310);
    return (j & ~255) + 128 * ((j >> 5) & 1) + 32 * ((j >> 6) & 3) + (j & 31);
}
__device__ __forceinline__ void tr_item(const float* W, int K, int N, bf16* WT, int kind, LAS float* scr, int item, int lane) {
    const int nblk = (N + 31) >> 5, kb = item / nblk, nb = item - kb * nblk, k0 = 64 * kb, n0 = 32 * nb;
    const int nn = n0 + (lane & 31);
#pragma unroll 8
    for (int i = 0; i < 32; ++i) { const int kk = 2 * i + (lane >> 5); scr[kk * 33 + (lane & 31)] = (nn < N) ? W[(size_t)(k0 + kk) * N + nn] : 0.f; }
    LDS_WAIT(); asm volatile("" ::: "memory");
    const int c = lane & 7;
#pragma unroll
    for (int j = 0; j < 4; ++j) { const int nl = (lane >> 3) + 8 * j; const int n = n0 + nl; const LAS float* s = scr + (8 * c) * 33 + nl;
        const int dr = (n < N) ? map_row(kind, n) : -1;
        if (dr >= 0) { u32x4 o; o.x = pk2(s[0 * 33], s[1 * 33]); o.y = pk2(s[2 * 33], s[3 * 33]); o.z = pk2(s[4 * 33], s[5 * 33]); o.w = pk2(s[6 * 33], s[7 * 33]);
            *(u32x4*)(WT + (size_t)dr * K + k0 + 8 * c) = o; } }
    LDS_WAIT(); asm volatile("" ::: "memory");
}
__device__ __forceinline__ void p0_prologue(const Frame& F, const Args& A) {
    if (blockIdx.x == 0 && F.tid < 27) ((const void**)(F.ws + WS_PTRS))[F.tid] = (F.tid < 26) ? (const void*)A.in[F.tid] : (const void*)A.out;
    LAS float* scr = (LAS float*)(F.lds + F.wave * 16384);
    const int gw = F.vcu * 8 + F.wave, NGW = F.G * 8;
    unsigned char* ws = F.ws;
    constexpr int I_IN = 16 * 81, I_OUT = 16 * 32, I_GLU = 4 * 8, I_FF = 1792;
    constexpr int S0 = NL * I_IN, S1 = S0 + NL * I_OUT, S2 = S1 + NL * I_GLU, S3 = S2 + 2 * I_FF  , S4 = S3 + 2 * I_FF  , S5 = S4 + 2 * I_FF  ,
                  S6 = S5 + 16 * I_FF  , S7 = S6 + 16 * I_FF  , S8 = S7 + 16 * I_FF  ;
    for (int it = gw; it < S8; it += NGW) {
        if (it < S0) { const int l = it / I_IN, r = it - l * I_IN; tr_item(A.in[IN_W_IN] + (size_t)l * DM * PROJW, DM, PROJW, (bf16*)(ws + WS_WIN) + (size_t)l * 2560 * DM, 1, scr, r, F.lane); }
        else if (it < S1) { const int q = it - S0, l = q / I_OUT, r = q - l * I_OUT; tr_item(A.in[IN_W_OUT] + (size_t)l * DM * DM, DM, DM, (bf16*)(ws + WS_WOUT) + (size_t)l * DM * DM, 0, scr, r, F.lane); }
        else if (it < S2) { const int q = it - S1, l = q / I_GLU, r = q - l * I_GLU; tr_item(A.in[IN_W_GLU] + (size_t)l * 65536, 256, 256, (bf16*)(ws + WS_WGLU) + (size_t)l * 65536, 0, scr, r, F.lane); }
        else if (it < S3) { const int q = it - S2, l = q / I_FF, r = q - l * I_FF; tr_item(A.in[IN_DGATE] + (size_t)l * DM * DFF, DM, DFF, (bf16*)(ws + WS_DGU) + (size_t)l * 7168 * DM, 2, scr, r, F.lane); }
        else if (it < S4) { const int q = it - S3, l = q / I_FF, r = q - l * I_FF; tr_item(A.in[IN_DUP] + (size_t)l * DM * DFF, DM, DFF, (bf16*)(ws + WS_DGU) + (size_t)l * 7168 * DM, 3, scr, r, F.lane); }
        else if (it < S5) { const int q = it - S4, l = q / I_FF, r = q - l * I_FF; tr_item(A.in[IN_DDOWN] + (size_t)l * DFF * DM, DFF, DM, (bf16*)(ws + WS_DDN) + (size_t)l * DM * DFF, 0, scr, r, F.lane); }
        else if (it < S6) { const int q = it - S5, l = q / I_FF, r = q - l * I_FF; tr_item(A.in[IN_MGATE] + (size_t)l * DM * DFF, DM, DFF, (bf16*)(ws + WS_MGU) + (size_t)l * 7168 * DM, 2, scr, r, F.lane); }
        else if (it < S7) { const int q = it - S6, l = q / I_FF, r = q - l * I_FF; tr_item(A.in[IN_MUP] + (size_t)l * DM * DFF, DM, DFF, (bf16*)(ws + WS_MGU) + (size_t)l * 7168 * DM, 3, scr, r, F.lane); }
        else { const int q = it - S7, l = q / I_FF, r = q - l * I_FF; tr_item(A.in[IN_MDOWN] + (size_t)l * DFF * DM, DFF, DM, (bf16*)(ws + WS_MDN) + (size_t)l * DM * DFF, 0, scr, r, F.lane); }
    }
    const int gt = F.vcu * 512 + F.tid;
    if (gt < NL * NG * NS) {
        const int n = gt & 63, lg = gt >> 6, g = lg & 15;
        const double are = (double)A.in[IN_A_RE][gt], aim = (double)A.in[IN_A_IM][gt];
        const double dt = exp((double)A.in[IN_LOG_DT][lg]);
        const double mag = exp(dt * are), ang = dt * aim;
        const double abr = mag * cos(ang), abi = mag * sin(ang);
        const double magL = exp((double)CH * dt * are), angL = (double)CH * ang;
        const double den = are * are + aim * aim, nr = abr - 1.0, ni = abi;
        const double cr = (nr * are + ni * aim) / den, ci = (ni * are - nr * aim) / den;
        float* tb = (float*)(ws + WS_S5T) + (size_t)lg * 2304;
        tb[n] = (float)abr; tb[64 + n] = (float)abi; tb[128 + n] = (float)(magL * cos(angL)); tb[192 + n] = (float)(magL * sin(angL));
        const float* bre = A.in[IN_B_RE] + (size_t)gt * SG; const float* bim = A.in[IN_B_IM] + (size_t)gt * SG;
        (void)g;
#pragma unroll
        for (int c = 0; c < SG; ++c) { const double br = bre[c], bi = bim[c]; tb[256 + n * 16 + c] = (float)(cr * br - ci * bi); tb[1280 + n * 16 + c] = (float)(cr * bi + ci * br); }
    }
}

template <int MODE>
__device__ __forceinline__ void norm_phase(const Frame& F, int layer, bool combine, const float* xsrc) {
    unsigned char* ws = F.ws;
    LAS float* wl = (LAS float*)F.lds;
    LAS int* rte = (LAS int*)(F.lds + 32768);
    if (MODE == 0) { const float* w = F.in[IN_W_IN] + (size_t)layer * DM * PROJW + 1152;
        for (int idx = F.tid; idx < 6 * DM; idx += 512) { const int k = idx / 6, h = idx - 6 * k; wl[h * DM + k] = w[(size_t)k * PROJW + h]; } }
    if (MODE == 2) { const float* w = F.in[IN_ROUTER] + (size_t)(layer >> 1) * DM * NE;
        for (int idx = F.tid; idx < NE * DM; idx += 512) { const int k = idx >> 3, e = idx & 7; wl[e * DM + k] = w[idx]; } }
    if (MODE == 0 || MODE == 2) __syncthreads();
    const float* gain = (MODE == 0 ? F.in[IN_ATTN_NORM] : F.in[IN_FFN_NORM]) + layer * DM;
    f32x4 gv[4];
    if (MODE != 3) {
#pragma unroll
        for (int j = 0; j < 4; ++j) gv[j] = *(const f32x4*)(gain + 4 * F.lane + 256 * j);
    }
    const bf16* Y = (const bf16*)(ws + WS_R2);
    for (int i = 0; i < 16; ++i) {
        const int li = F.wave + 8 * i, tok = 128 * F.vcu + li;
        f32x4 v[4];
#pragma unroll
        for (int j = 0; j < 4; ++j) v[j] = *(const f32x4*)(xsrc + (size_t)tok * DM + 4 * F.lane + 256 * j);
        if (combine) {
            const int2 tr = *(const int2*)(ws + WS_TOKROW + (size_t)tok * 8); const f32x2 rw = *(const f32x2*)(ws + WS_RTW + (size_t)tok * 8);
#pragma unroll
            for (int j = 0; j < 4; ++j) {
                const u32x2 a = *(const u32x2*)(Y + (size_t)tr.x * DM + 4 * F.lane + 256 * j), b = *(const u32x2*)(Y + (size_t)tr.y * DM + 4 * F.lane + 256 * j);
                v[j][0] += rw.x * bf2f((unsigned short)(a.x & 0xffff)) + rw.y * bf2f((unsigned short)(b.x & 0xffff));
                v[j][1] += rw.x * bf2f((unsigned short)(a.x >> 16)) + rw.y * bf2f((unsigned short)(b.x >> 16));
                v[j][2] += rw.x * bf2f((unsigned short)(a.y & 0xffff)) + rw.y * bf2f((unsigned short)(b.y & 0xffff));
                v[j][3] += rw.x * bf2f((unsigned short)(a.y >> 16)) + rw.y * bf2f((unsigned short)(b.y >> 16));
                *(f32x4*)(F.out + (size_t)tok * DM + 4 * F.lane + 256 * j) = v[j];
            }
        }
        if (MODE == 3) continue;
        float ss = 0.f;
#pragma unroll
        for (int j = 0; j < 4; ++j) ss += (v[j][0] * v[j][0] + v[j][1] * v[j][1]) + (v[j][2] * v[j][2] + v[j][3] * v[j][3]);
        const float r = __builtin_amdgcn_rsqf(wave_sum(ss) * (1.f / DM) + EPS);
        bf16* xn = (bf16*)(ws + WS_XN) + (size_t)tok * DM;
#pragma unroll
        for (int j = 0; j < 4; ++j) { v[j] = v[j] * r * gv[j]; u32x2 w; w.x = pk2(v[j][0], v[j][1]); w.y = pk2(v[j][2], v[j][3]); *(u32x2*)(xn + 4 * F.lane + 256 * j) = w; }
        if (MODE == 0) {
            float fg[6];
#pragma unroll
            for (int h = 0; h < 6; ++h) { float s = 0.f;
#pragma unroll
                for (int j = 0; j < 4; ++j) { const f32x4 w = *(const LAS f32x4*)(wl + h * DM + 4 * F.lane + 256 * j); s += (v[j][0] * w[0] + v[j][1] * w[1]) + (v[j][2] * w[2] + v[j][3] * w[3]); }
                fg[h] = wave_sum(s); }
            if (F.lane < 6) {
                float x = fg[0];
#pragma unroll
                for (int h = 1; h < 6; ++h) x = (F.lane == h) ? fg[h] : x;
                x += F.in[IN_B_FORGET][layer * 6 + F.lane];
                const float lf = fminf(x, 0.f) - log1pf(expf(-fabsf(x)));
                const int b = tok / SEQ, s = tok - b * SEQ;
                ((float*)(ws + WS_LOGF))[(size_t)(b * 6 + F.lane) * SEQ + s] = lf;
            }
        }
        if (MODE == 2) {
            float lg[8];
#pragma unroll
            for (int e = 0; e < 8; ++e) { float s = 0.f;
#pragma unroll
                for (int j = 0; j < 4; ++j) { const f32x4 w = *(const LAS f32x4*)(wl + e * DM + 4 * F.lane + 256 * j); s += (v[j][0] * w[0] + v[j][1] * w[1]) + (v[j][2] * w[2] + v[j][3] * w[3]); }
                lg[e] = wave_sum(s); }
            int e1 = 0; float v1 = lg[0];
#pragma unroll
            for (int e = 1; e < 8; ++e) if (lg[e] > v1) { v1 = lg[e]; e1 = e; }
            int e2 = -1; float v2 = -INFINITY;
#pragma unroll
            for (int e = 0; e < 8; ++e) if (e != e1 && lg[e] > v2) { v2 = lg[e]; e2 = e; }
            const float w1 = 1.f / (1.f + expf(v2 - v1));
            if (F.lane == 0) { *(int2*)(ws + WS_RTE + (size_t)tok * 8) = make_int2(e1, e2); *(f32x2*)(ws + WS_RTW + (size_t)tok * 8) = (f32x2){w1, 1.f - w1}; rte[2 * li] = e1; rte[2 * li + 1] = e2; }
        }
    }
    if (MODE == 2) {
        __syncthreads();
        if (F.wave == 0) {
            const int a1 = rte[2 * F.lane], a2 = rte[2 * F.lane + 1], b1 = rte[2 * (64 + F.lane)], b2 = rte[2 * (64 + F.lane) + 1];
            const unsigned long long lt = (1ull << F.lane) - 1ull;
            int ra1 = 0, ra2 = 0, rb1 = 0, rb2 = 0, mycnt = 0;
#pragma unroll
            for (int e = 0; e < 8; ++e) {
                const unsigned long long m0 = __ballot(a1 == e || a2 == e), m1 = __ballot(b1 == e || b2 == e);
                const int r0 = __popcll(m0 & lt), r1 = __popcll(m0) + __popcll(m1 & lt);
                if (a1 == e) ra1 = r0; if (a2 == e) ra2 = r0; if (b1 == e) rb1 = r1; if (b2 == e) rb2 = r1;
                if (F.lane == e) mycnt = __popcll(m0) + __popcll(m1);
            }
            *(int2*)(ws + WS_LRANK + (size_t)(128 * F.vcu + F.lane) * 8) = make_int2(ra1, ra2);
            *(int2*)(ws + WS_LRANK + (size_t)(128 * F.vcu + 64 + F.lane) * 8) = make_int2(rb1, rb2);
            if (F.lane < 8) ((int*)(ws + WS_WGCNT))[F.vcu * 8 + F.lane] = mycnt;
        }
    }
}

__device__ __forceinline__ void moe_gather_phase(const Frame& F) {
    unsigned char* ws = F.ws;
    LAS int* sh = (LAS int*)F.lds;
    const int* wc = (const int*)(ws + WS_WGCNT);
    {
        const int e = F.wave; int tot = 0, pre = 0;
#pragma unroll
        for (int j = 0; j < 4; ++j) { const int w = F.lane + 64 * j; const int c = wc[w * 8 + e]; tot += c; pre += (w < F.vcu) ? c : 0; }
#pragma unroll
        for (int o = 1; o < 64; o <<= 1) { tot += __shfl_xor(tot, o); pre += __shfl_xor(pre, o); }
        if (F.lane == 0) { sh[e] = tot; sh[8 + e] = pre; }
    }
    __syncthreads();
    if (F.tid == 0) { int b = 0; for (int e = 0; e < 8; ++e) { sh[16 + e] = b; b += (sh[e] + 255) & ~255; } sh[24] = b;
        if (F.vcu == 0) { int* mb = (int*)(ws + WS_MOEB); for (int e = 0; e < 9; ++e) mb[e] = sh[16 + e] >> 8; } }
    __syncthreads();
    const bf16* XN = (const bf16*)(ws + WS_XN); bf16* AG = (bf16*)(ws + WS_R2);
    for (int i = 0; i < 16; ++i) {
        const int tok = 128 * F.vcu + F.wave + 8 * i;
        const int2 ee = *(const int2*)(ws + WS_RTE + (size_t)tok * 8), rk = *(const int2*)(ws + WS_LRANK + (size_t)tok * 8);
        const int r1 = sh[16 + ee.x] + sh[8 + ee.x] + rk.x, r2 = sh[16 + ee.y] + sh[8 + ee.y] + rk.y;
        const u32x4* src = (const u32x4*)(XN + (size_t)tok * DM);
        const u32x4 a = src[F.lane], b = src[64 + F.lane];
        u32x4* d1 = (u32x4*)(AG + (size_t)r1 * DM); u32x4* d2 = (u32x4*)(AG + (size_t)r2 * DM);
        d1[F.lane] = a; d1[64 + F.lane] = b; d2[F.lane] = a; d2[64 + F.lane] = b;
        if (F.lane == 0) *(int2*)(ws + WS_TOKROW + (size_t)tok * 8) = make_int2(r1, r2);
    }
}

__device__ __forceinline__ void cumsum_phase(const Frame& F) {
    if (F.vcu >= 24) return;
    unsigned char* ws = F.ws;
    LAS float* sh = (LAS float*)F.lds;
    const float* lf = (const float*)(ws + WS_LOGF) + (size_t)F.vcu * SEQ + 16 * F.tid;
    float v[16];
#pragma unroll
    for (int j = 0; j < 4; ++j) { const f32x4 x = *(const f32x4*)(lf + 4 * j); v[4 * j] = x[0]; v[4 * j + 1] = x[1]; v[4 * j + 2] = x[2]; v[4 * j + 3] = x[3]; }
#pragma unroll
    for (int j = 1; j < 16; ++j) v[j] += v[j - 1];
    float run = v[15];
#pragma unroll
    for (int o = 1; o < 64; o <<= 1) { const float t = __shfl_up(run, o); if (F.lane >= o) run += t; }
    if (F.lane == 63) sh[F.wave] = run;
    __syncthreads();
    float base = run - v[15];
    for (int w = 0; w < F.wave; ++w) base += sh[w];
    float* c2 = (float*)(ws + WS_C2) + (size_t)F.vcu * SEQ + 16 * F.tid;
#pragma unroll
    for (int j = 0; j < 4; ++j) *(f32x4*)(c2 + 4 * j) = (f32x4){(base + v[4 * j]) * LOG2E, (base + v[4 * j + 1]) * LOG2E, (base + v[4 * j + 2]) * LOG2E, (base + v[4 * j + 3]) * LOG2E};
    __syncthreads();
}

__device__ __forceinline__ bf16x8 pack8(const f32x16& p, int s) {
    u32x4 w; w.x = pk2(p[8 * s], p[8 * s + 1]); w.y = pk2(p[8 * s + 2], p[8 * s + 3]); w.z = pk2(p[8 * s + 4], p[8 * s + 5]); w.w = pk2(p[8 * s + 6], p[8 * s + 7]);
    return __builtin_bit_cast(bf16x8, w);
}
__device__ __forceinline__ float sumsq8(bf16x8 v) { float s = 0.f;
#pragma unroll
    for (int j = 0; j < 8; ++j) { const float f = bf2f((unsigned short)v[j]); s += f * f; } return s; }

template <bool FOX>
__device__ __forceinline__ void attn_item(const Frame& F, int layer, int b, int h, int qb, float kbound) {
    unsigned char* ws = F.ws;
    const int lane = F.lane, q = lane & 31, hh = lane >> 5;
    const size_t tok0 = (size_t)b * SEQ; const int q0 = qb * 32, qa = q0 + q;
    const bf16* Qb = (const bf16*)(ws + (FOX ? WS_FQ : WS_SQ)); const bf16* Kb = (const bf16*)(ws + (FOX ? WS_FK : WS_SK));
    const bf16* Vt = (const bf16*)(ws + WS_VT) + (size_t)((FOX ? 0 : 384) + h * 64) * T;
    bf16x8 qf[4];
#pragma unroll
    for (int ks = 0; ks < 4; ++ks) qf[ks] = *(const bf16x8*)(Qb + (tok0 + qa) * 384 + h * 64 + 16 * ks + 8 * hh);
    const int krow = 32 * ((q >> 2) & 1) + 8 * (q >> 4) + 4 * ((q >> 3) & 1) + (q & 3);
    const bf16* Kp = Kb + (tok0 + krow) * 384 + h * 64 + 8 * hh;
    const bf16* Vp = Vt + (size_t)q * T + tok0 + 32 * hh;
    const float* c2 = (const float*)(ws + WS_C2) + (size_t)(b * 6 + h) * SEQ;
    float ct = 0.f, qk = 0.f;
    if (FOX) { ct = c2[qa]; float qs = sumsq8(qf[0]) + sumsq8(qf[1]) + sumsq8(qf[2]) + sumsq8(qf[3]); qs += __shfl_xor(qs, 32); qk = sqrtf(qs) * kbound; }
    float m = -INFINITY, l = 0.f, carry = 1.f;
    f32x16 o0, o1;
#pragma unroll
    for (int r = 0; r < 16; ++r) { o0[r] = 0.f; o1[r] = 0.f; }
    const int ktd = q0 >> 6;
    for (int kt = ktd; kt >= 0; --kt) {
        bf16x8 kf[2][4];
#pragma unroll
        for (int blk = 0; blk < 2; ++blk)
#pragma unroll
            for (int ks = 0; ks < 4; ++ks) kf[blk][ks] = *(const bf16x8*)(Kp + (size_t)(64 * kt + 16 * blk) * 384 + 16 * ks);
        bf16x8 vf[2][2][2];
#pragma unroll
        for (int db = 0; db < 2; ++db)
#pragma unroll
            for (int blk = 0; blk < 2; ++blk)
#pragma unroll
                for (int s = 0; s < 2; ++s) vf[db][blk][s] = *(const bf16x8*)(Vp + (size_t)(32 * db) * T + 64 * kt + 16 * blk + 8 * s);
        f32x16 p0, p1;
#pragma unroll
        for (int r = 0; r < 16; ++r) { p0[r] = 0.f; p1[r] = 0.f; }
#pragma unroll
        for (int ks = 0; ks < 4; ++ks) { p0 = __builtin_amdgcn_mfma_f32_32x32x16_bf16(kf[0][ks], qf[ks], p0, 0, 0, 0); p1 = __builtin_amdgcn_mfma_f32_32x32x16_bf16(kf[1][ks], qf[ks], p1, 0, 0, 0); }
        const int kbase = 64 * kt + 32 * hh;
        if (FOX) {
            const float* cp = c2 + kbase;
#pragma unroll
            for (int j = 0; j < 4; ++j) { const f32x4 ca = *(const f32x4*)(cp + 4 * j), cb = *(const f32x4*)(cp + 16 + 4 * j);
#pragma unroll
                for (int i = 0; i < 4; ++i) { p0[4 * j + i] += ct - ca[i]; p1[4 * j + i] += ct - cb[i]; } }
            if (kt == ktd) {
#pragma unroll
                for (int r = 0; r < 16; ++r) { if (kbase + r > qa) p0[r] = -INFINITY; if (kbase + 16 + r > qa) p1[r] = -INFINITY; }
            }
            float tm = fmaxf(p0[0], p1[0]);
#pragma unroll
            for (int r = 1; r < 16; ++r) tm = fmaxf(tm, fmaxf(p0[r], p1[r]));
            tm = fmaxf(tm, __shfl_xor(tm, 32));
            const float mn = fmaxf(m, tm), alpha = fexp2(m - mn);
            float ls = 0.f;
#pragma unroll
            for (int r = 0; r < 16; ++r) { p0[r] = fexp2(p0[r] - mn); p1[r] = fexp2(p1[r] - mn); ls += p0[r] + p1[r]; }
            l = l * alpha + ls; m = mn;
#pragma unroll
            for (int r = 0; r < 16; ++r) { o0[r] *= alpha; o1[r] *= alpha; }
        } else {
            float om[32];
            const bool diag = (kt == ktd);
#pragma unroll
            for (int r = 0; r < 16; ++r) {
                { const float e = fexp2(fminf(p0[r], 80.f)); float t = frcp(1.f + e); float bt = e * t; if (diag && kbase + r >= qa) { bt = 0.f; t = 1.f; } p0[r] = bt; om[r] = t; }
                { const float e = fexp2(fminf(p1[r], 80.f)); float t = frcp(1.f + e); float bt = e * t; if (diag && kbase + 16 + r >= qa) { bt = 0.f; t = 1.f; } p1[r] = bt; om[16 + r] = t; }
            }
            float run = 1.f;
#pragma unroll
            for (int r = 15; r >= 0; --r) { p1[r] *= run; run *= om[16 + r]; }
#pragma unroll
            for (int r = 15; r >= 0; --r) { p0[r] *= run; run *= om[r]; }
            const float other = __shfl_xor(run, 32);
            const float lc = carry * (hh == 0 ? other : 1.f);
#pragma unroll
            for (int r = 0; r < 16; ++r) { p0[r] *= lc; p1[r] *= lc; }
            carry *= run * other;
        }
        const bf16x8 pb00 = pack8(p0, 0), pb01 = pack8(p0, 1), pb10 = pack8(p1, 0), pb11 = pack8(p1, 1);
        o0 = __builtin_amdgcn_mfma_f32_32x32x16_bf16(vf[0][0][0], pb00, o0, 0, 0, 0); o0 = __builtin_amdgcn_mfma_f32_32x32x16_bf16(vf[0][0][1], pb01, o0, 0, 0, 0);
        o0 = __builtin_amdgcn_mfma_f32_32x32x16_bf16(vf[0][1][0], pb10, o0, 0, 0, 0); o0 = __builtin_amdgcn_mfma_f32_32x32x16_bf16(vf[0][1][1], pb11, o0, 0, 0, 0);
        o1 = __builtin_amdgcn_mfma_f32_32x32x16_bf16(vf[1][0][0], pb00, o1, 0, 0, 0); o1 = __builtin_amdgcn_mfma_f32_32x32x16_bf16(vf[1][0][1], pb01, o1, 0, 0, 0);
        o1 = __builtin_amdgcn_mfma_f32_32x32x16_bf16(vf[1][1][0], pb10, o1, 0, 0, 0); o1 = __builtin_amdgcn_mfma_f32_32x32x16_bf16(vf[1][1][1], pb11, o1, 0, 0, 0);
        if (kt > 0) {
            if (FOX) { const float ub = qk + ct - c2[64 * kt]; if (__all(ub < m - 50.f)) break; }
            else { if (__all(carry < 7.8e-31f)) break; }
        }
    }
    float inv = 1.f;
    if (FOX) { const float lt = l + __shfl_xor(l, 32); inv = 1.f / lt; }
    float ss = 0.f;
#pragma unroll
    for (int r = 0; r < 16; ++r) { o0[r] *= inv; o1[r] *= inv; ss += o0[r] * o0[r] + o1[r] * o1[r]; }
    ss += __shfl_xor(ss, 32);
    const float rn = __builtin_amdgcn_rsqf(ss * (1.f / 64.f) + EPS);
    const int colb = (FOX ? 0 : 384) + h * 64 + 4 * hh;
    const float* on = F.in[IN_OUT_NORM] + layer * DM + colb;
    bf16* dst = (bf16*)(ws + WS_MIX) + (tok0 + qa) * DM + colb;
#pragma unroll
    for (int g = 0; g < 4; ++g) {
        const f32x4 g0 = *(const f32x4*)(on + 8 * g), g1 = *(const f32x4*)(on + 32 + 8 * g);
        u32x2 w0, w1;
        w0.x = pk2(o0[4 * g] * rn * g0[0], o0[4 * g + 1] * rn * g0[1]); w0.y = pk2(o0[4 * g + 2] * rn * g0[2], o0[4 * g + 3] * rn * g0[3]);
        w1.x = pk2(o1[4 * g] * rn * g1[0], o1[4 * g + 1] * rn * g1[1]); w1.y = pk2(o1[4 * g + 2] * rn * g1[2], o1[4 * g + 3] * rn * g1[3]);
        *(u32x2*)(dst + 8 * g) = w0; *(u32x2*)(dst + 32 + 8 * g) = w1;
    }
}

__device__ __forceinline__ void s5_chunk_state(const Frame& F, int layer, int b, int g, int k) {
    unsigned char* ws = F.ws;
    LAS float* us = (LAS float*)(F.lds + F.wave * 4096);
    const float* tb = (const float*)(ws + WS_S5T) + (size_t)(layer * NG + g) * 2304;
    const int n = F.lane;
    const float ar = tb[n], ai = tb[64 + n];
    f32x4 br[4], bi[4];
#pragma unroll
    for (int j = 0; j < 4; ++j) { br[j] = *(const f32x4*)(tb + 256 + n * 16 + 4 * j); bi[j] = *(const f32x4*)(tb + 1280 + n * 16 + 4 * j); }
    const float* up = (const float*)(ws + WS_SU) + ((size_t)b * SEQ + 64 * k + F.lane) * SSMW + 16 * g;
#pragma unroll
    for (int j = 0; j < 4; ++j) *(LAS f32x4*)(us + F.lane * 16 + 4 * j) = *(const f32x4*)(up + 4 * j);
    LDS_WAIT();
    float hr = 0.f, hi = 0.f;
    for (int t = 0; t < CH; ++t) {
        float sr = 0.f, si = 0.f;
#pragma unroll
        for (int j = 0; j < 4; ++j) { const f32x4 u = *(const LAS f32x4*)(us + t * 16 + 4 * j);
            sr += (br[j][0] * u[0] + br[j][1] * u[1]) + (br[j][2] * u[2] + br[j][3] * u[3]); si += (bi[j][0] * u[0] + bi[j][1] * u[1]) + (bi[j][2] * u[2] + bi[j][3] * u[3]); }
        const float nr = ar * hr - ai * hi + sr, ni = ar * hi + ai * hr + si; hr = nr; hi = ni;
    }
    ((f32x2*)(ws + WS_SEND))[((size_t)(b * NG + g) * NCH + k) * 64 + n] = (f32x2){hr, hi};
    LDS_WAIT();
}

__device__ __forceinline__ void attn_phase(const Frame& F, int layer) {
    const float kg = fabsf(F.in[IN_FKN][layer * 64 + F.lane]);
    const float kbound = wave_max(kg) * 8.f * 1.01f;
    gu32* head = F.ctl + CW_QHEAD + 64 * layer;
    constexpr int NATT = 24 * 256;
    for (;;) {
        unsigned t = 0u; if (F.lane == 0) t = __hip_atomic_fetch_add(head, 1u, RLX_AGENT);
        const int idx = __builtin_amdgcn_readfirstlane((int)t);
        if (idx >= 2 * NATT + NB * NG * NCH) break;
        if (idx < 2 * NATT) {
            const int j = (idx < NATT) ? idx : idx - NATT;
            const int bh = j >> 8, qb = 255 - (j & 255);
            if (idx < NATT) attn_item<true>(F, layer, bh / 6, bh % 6, qb, kbound);
            else attn_item<false>(F, layer, bh / 6, bh % 6, qb, kbound);
        } else {
            const int j = idx - 2 * NATT; s5_chunk_state(F, layer, j >> 11, (j >> 7) & 15, j & 127);
        }
    }
}

__device__ __forceinline__ float gelu_tanh(float x) { const float u = 0.7978845608028654f * (x + 0.044715f * x * x * x); return x * frcp(1.f + fexp2(-2.f * LOG2E * u)); }
constexpr int S5_WLDS = 12800, S5_HS = 132, S5_GOFF = 8 * S5_WLDS, S5_GP = 264;
__device__ __forceinline__ void s5_out_phase(const Frame& F, int layer) {
    unsigned char* ws = F.ws;
    LAS float* us = (LAS float*)(F.lds + F.wave * S5_WLDS);
    LAS float* hs = us + 1024;
    LAS bf16* G = (LAS bf16*)(F.lds + S5_GOFF);
    const int lane = F.lane, n = lane, c16 = lane & 15, kq = lane >> 4;
    for (int unit = F.vcu; unit < NB * NCH; unit += F.G) {
        const int b = unit / NCH, k = unit - b * NCH;
        for (int gi = 0; gi < 2; ++gi) {
            const int g = 2 * F.wave + gi;
            const float* tb = (const float*)(ws + WS_S5T) + (size_t)(layer * NG + g) * 2304;
            const float ar = tb[n], ai = tb[64 + n], lr = tb[128 + n], li = tb[192 + n];
            f32x4 br[4], bi[4];
#pragma unroll
            for (int j = 0; j < 4; ++j) { br[j] = *(const f32x4*)(tb + 256 + n * 16 + 4 * j); bi[j] = *(const f32x4*)(tb + 1280 + n * 16 + 4 * j); }
            float hr = 0.f, hi = 0.f;
            const f32x2* se = (const f32x2*)(ws + WS_SEND) + (size_t)(b * NG + g) * NCH * 64 + n;
            for (int kk = 0; kk < k; ++kk) { const f32x2 s = se[(size_t)kk * 64]; const float nr = lr * hr - li * hi + s.x, ni = lr * hi + li * hr + s.y; hr = nr; hi = ni; }
            const float* cre = F.in[IN_C_RE] + ((size_t)(layer * NG + g) * SG + c16) * NS; const float* cim = F.in[IN_C_IM] + ((size_t)(layer * NG + g) * SG + c16) * NS;
            float cm[32];
#pragma unroll
            for (int ks = 0; ks < 16; ++ks) { cm[ks] = cre[4 * ks + kq]; cm[16 + ks] = -cim[4 * ks + kq]; }
            const float dsk = F.in[IN_SSM_D][layer * SSMW + 16 * g + c16];
            const float* up = (const float*)(ws + WS_SU) + ((size_t)b * SEQ + 64 * k + lane) * SSMW + 16 * g;
#pragma unroll
            for (int j = 0; j < 4; ++j) *(LAS f32x4*)(us + lane * 16 + 4 * j) = *(const f32x4*)(up + 4 * j);
            LDS_WAIT();
            for (int sc = 0; sc < 4; ++sc) {
                for (int t = 0; t < 16; ++t) {
                    float sr = 0.f, si = 0.f;
#pragma unroll
                    for (int j = 0; j < 4; ++j) { const f32x4 u = *(const LAS f32x4*)(us + (16 * sc + t) * 16 + 4 * j);
                        sr += (br[j][0] * u[0] + br[j][1] * u[1]) + (br[j][2] * u[2] + br[j][3] * u[3]); si += (bi[j][0] * u[0] + bi[j][1] * u[1]) + (bi[j][2] * u[2] + bi[j][3] * u[3]); }
                    const float nr = ar * hr - ai * hi + sr, ni = ar * hi + ai * hr + si; hr = nr; hi = ni;
                    hs[t * S5_HS + n] = hr; hs[t * S5_HS + 64 + n] = hi;
                }
                LDS_WAIT();
                f32x4 y = {0.f, 0.f, 0.f, 0.f};
#pragma unroll
                for (int ks = 0; ks < 32; ++ks) { const float a = hs[c16 * S5_HS + 4 * ks + kq]; y = __builtin_amdgcn_mfma_f32_16x16x4f32(a, cm[ks], y, 0, 0, 0); }
#pragma unroll
                for (int i = 0; i < 4; ++i) { const int tl = 16 * sc + 4 * kq + i; const float yy = y[i] + dsk * us[tl * 16 + c16]; G[tl * S5_GP + 16 * g + c16] = (bf16)f2bf(gelu_tanh(yy)); }
                LDS_WAIT();
            }
        }
        __syncthreads();
        {
            const bf16* Wt = (const bf16*)(ws + WS_WGLU) + (size_t)layer * 65536;
            f32x4 z[4][2];
#pragma unroll
            for (int rb = 0; rb < 4; ++rb)
#pragma unroll
                for (int cb = 0; cb < 2; ++cb) z[rb][cb] = (f32x4){0.f, 0.f, 0.f, 0.f};
#pragma unroll
            for (int ks = 0; ks < 8; ++ks) {
                bf16x8 bfr[2], afr[4];
#pragma unroll
                for (int cb = 0; cb < 2; ++cb) bfr[cb] = *(const bf16x8*)(Wt + (size_t)(32 * F.wave + 16 * cb + c16) * 256 + 32 * ks + 8 * kq);
#pragma unroll
                for (int rb = 0; rb < 4; ++rb) afr[rb] = *(const LAS bf16x8*)(G + (16 * rb + c16) * S5_GP + 32 * ks + 8 * kq);
#pragma unroll
                for (int rb = 0; rb < 4; ++rb)
#pragma unroll
                    for (int cb = 0; cb < 2; ++cb) z[rb][cb] = __builtin_amdgcn_mfma_f32_16x16x32_bf16(afr[rb], bfr[cb], z[rb][cb], 0, 0, 0);
            }
#pragma unroll
            for (int cb = 0; cb < 2; ++cb) {
                const int oc = 32 * F.wave + 16 * cb + c16;
                const float bg = F.in[IN_B_GLU][layer * SSMW + oc], on = F.in[IN_OUT_NORM][layer * DM + 768 + oc];
#pragma unroll
                for (int rb = 0; rb < 4; ++rb)
#pragma unroll
                    for (int i = 0; i < 4; ++i) {
                        const int tl = 16 * rb + 4 * kq + i;
                        const float gg = bf2f(G[tl * S5_GP + oc]);
                        const float v = gg * frcp(1.f + fexp2(-(z[rb][cb][i] + bg) * LOG2E));
                        float ss = v * v; ss += __shfl_xor(ss, 1); ss += __shfl_xor(ss, 2); ss += __shfl_xor(ss, 4); ss += __shfl_xor(ss, 8);
                        const float o = v * __builtin_amdgcn_rsqf(ss * (1.f / 16.f) + EPS) * on;
                        ((bf16*)(ws + WS_MIX))[((size_t)b * SEQ + 64 * k + tl) * DM + 768 + oc] = (bf16)f2bf(o);
                    }
            }
        }
        __syncthreads();
    }
}

#ifndef PHM
#define PHM 0xffff
#endif
__device__ __forceinline__ Frame make_frame(unsigned char* ws_in, LAS unsigned char* lds) {
    Frame F; unsigned char* ws = ws_in; asm volatile("" : "+s"(ws));
    int tid = threadIdx.x; asm volatile("" : "+v"(tid));
    F.lds = lds; F.tid = tid; F.lane = tid & 63; F.wave = __builtin_amdgcn_readfirstlane(tid >> 6);
    F.G = gridDim.x; { const int bx = blockIdx.x; F.vcu = (bx % 8) * (F.G / 8) + bx / 8; }
    F.ws = ws; F.ctl = (gu32*)(ws + WS_CTL); F.in = (const float* const*)(ws + WS_PTRS); F.out = nullptr;
    return F;
}
__global__ void __launch_bounds__(512, 2) hybrid_fwd(Args args) {
    extern __shared__ __attribute__((aligned(16))) unsigned char lds_raw[];
    LAS unsigned char* const lds = (LAS unsigned char*)lds_raw;
    for (int u = threadIdx.x; u < (LDS_BYTES - LDS_CTL) / 4; u += 512) ((LAS unsigned*)(lds + LDS_CTL))[u] = 0u;
    __syncthreads();
    XcdBarrier bar = xcd_barrier_post((unsigned*)(args.ws + WS_CTL) + CW_BAR + args.li * XCD_BAR_WORDS, (volatile LAS unsigned*)(lds + LDS_CTL) + 8);
    const int lo = args.ph_lo, hi = args.ph_hi;
    int ph = 0;
#define PH_BEGIN if (ph >= lo && ph < hi) { Frame F = make_frame(args.ws, lds); unsigned char* const ws = F.ws; (void)ws; int layer = layer_; asm volatile("" : "+s"(layer)); const bool moe = (layer & 1) != 0; const int j2 = layer >> 1; (void)moe; (void)j2;
#define PH_END   if (ph + 1 < hi) xcd_barrier(bar); } ++ph;
    const size_t TS1 = (size_t)256 * DM * 2, TS3 = (size_t)256 * DFF * 2;

    { const int layer_ = 0; PH_BEGIN F.out = args.out; if (PHM & 1) p0_prologue(F, args); PH_END }

    for (int layer_ = 0; layer_ < NL; ++layer_) {
        PH_BEGIN F.out = (float*)F.in[26]; if (PHM & 2) norm_phase<0>(F, layer, layer > 0 && ((layer - 1) & 1), (layer == 0) ? F.in[IN_X] : F.out); PH_END
        PH_BEGIN
            if (PHM & 4) cumsum_phase(F);
            __syncthreads();
            { const pg8::SchedLds S = pg8::build_units_plain(F.lds, F.tid, F.G, (int)blockIdx.x, T / 256, NQK / 256, (const char*)(ws + WS_XN), (const char*)(ws + WS_WIN) + (size_t)layer * 2560 * DM * 2, TS1);
              pg8::EpiProj E{(bf16*)(ws + WS_FQ), (bf16*)(ws + WS_FK), (bf16*)(ws + WS_SQ), (bf16*)(ws + WS_SK), (float*)(ws + WS_SU), F.in[IN_FQN] + layer * 64, F.in[IN_FKN] + layer * 64};
              if (PHM & 8) pg8::gemm_phase<pg8::EpiProj, pg8::SchedLds, true, true>(F.lds, F.tid, DM, S, E); }
            { const pg8::SchedLds S = pg8::build_units_plain(F.lds, F.tid, F.G, (int)blockIdx.x, NVT / 256, T / 256, (const char*)(ws + WS_WIN) + ((size_t)layer * 2560 + NQK) * DM * 2, (const char*)(ws + WS_XN), TS1);
              pg8::EpiStoreBf16 E{(bf16*)(ws + WS_VT), T, 0};
              if (PHM & 16) pg8::gemm_phase<pg8::EpiStoreBf16, pg8::SchedLds, true, true>(F.lds, F.tid, DM, S, E); }
        PH_END
        PH_BEGIN if (PHM & 32) attn_phase(F, layer); PH_END
        PH_BEGIN if (PHM & 64) s5_out_phase(F, layer); PH_END
        PH_BEGIN
            { float* const outp = (float*)F.in[26];
              const pg8::SchedLds S = pg8::build_units_plain(F.lds, F.tid, F.G, (int)blockIdx.x, T / 256, DM / 256, (const char*)(ws + WS_MIX), (const char*)(ws + WS_WOUT) + (size_t)layer * DM * DM * 2, TS1);
              pg8::EpiResid E{(layer == 0) ? F.in[IN_X] : (const float*)outp, outp};
              if (PHM & 128) pg8::gemm_phase<pg8::EpiResid, pg8::SchedLds, true, true>(F.lds, F.tid, DM, S, E); }
        PH_END
        if (!(layer_ & 1)) {
            PH_BEGIN F.out = (float*)F.in[26]; if (PHM & 256) norm_phase<1>(F, layer, false, F.out); PH_END
            PH_BEGIN
                { const pg8::SchedLds S = pg8::build_units_plain(F.lds, F.tid, F.G, (int)blockIdx.x, T / 256, 28, (const char*)(ws + WS_XN), (const char*)(ws + WS_DGU) + (size_t)j2 * 7168 * DM * 2, TS1);
                  pg8::EpiSwiglu E{(bf16*)(ws + WS_HID), 0};
                  if (PHM & 512) pg8::gemm_phase<pg8::EpiSwiglu, pg8::SchedLds, true, true>(F.lds, F.tid, DM, S, E); }
            PH_END
            PH_BEGIN
                { float* const outp = (float*)F.in[26];
                  const pg8::SchedLds S = pg8::build_units_plain(F.lds, F.tid, F.G, (int)blockIdx.x, T / 256, DM / 256, (const char*)(ws + WS_HID), (const char*)(ws + WS_DDN) + (size_t)j2 * DM * DFF * 2, TS3);
                  pg8::EpiResid E{outp, outp};
                  if (PHM & 1024) pg8::gemm_phase<pg8::EpiResid, pg8::SchedLds, true, true>(F.lds, F.tid, DFF, S, E); }
            PH_END
        } else {
            PH_BEGIN F.out = (float*)F.in[26]; if (PHM & 2048) norm_phase<2>(F, layer, false, F.out); PH_END
            PH_BEGIN if (PHM & 4096) moe_gather_phase(F); PH_END
            for (int pass_ = 0; pass_ < 2; ++pass_) {
                PH_BEGIN int pass = pass_; asm volatile("" : "+s"(pass));
                    { const int* mb = (const int*)(ws + WS_MOEB); const int ntl = mb[8]; const int tlo = pass * MOE_PASS_TILES; int nM = ntl - tlo; nM = nM < 0 ? 0 : (nM > MOE_PASS_TILES ? MOE_PASS_TILES : nM);
                      const pg8::SchedLds S = pg8::build_units_moe(F.lds, F.tid, F.G, (int)blockIdx.x, nM, 28, tlo, mb, (const char*)(ws + WS_R2), (const char*)(ws + WS_MGU) + (size_t)j2 * 8 * 7168 * DM * 2, TS1, TS1, (size_t)7168 * DM * 2, false);
                      pg8::EpiSwiglu E{(bf16*)(ws + WS_HID), tlo};
                      if (PHM & 8192) pg8::gemm_phase<pg8::EpiSwiglu, pg8::SchedLds, true, true>(F.lds, F.tid, DM, S, E); }
                PH_END
                PH_BEGIN int pass = pass_; asm volatile("" : "+s"(pass));
                    { const int* mb = (const int*)(ws + WS_MOEB); const int ntl = mb[8]; const int tlo = pass * MOE_PASS_TILES; int nM = ntl - tlo; nM = nM < 0 ? 0 : (nM > MOE_PASS_TILES ? MOE_PASS_TILES : nM);
                      const pg8::SchedLds S = pg8::build_units_moe(F.lds, F.tid, F.G, (int)blockIdx.x, nM, DM / 256, tlo, mb, (const char*)(ws + WS_HID), (const char*)(ws + WS_MDN) + (size_t)j2 * 8 * DM * DFF * 2, TS3, TS3, (size_t)DM * DFF * 2, true);
                      pg8::EpiStoreBf16 E{(bf16*)(ws + WS_R2), DM, 0};
                      if (PHM & 16384) pg8::gemm_phase<pg8::EpiStoreBf16, pg8::SchedLds, true, true>(F.lds, F.tid, DFF, S, E); }
                PH_END
            }
        }
    }
    { const int layer_ = NL; PH_BEGIN F.out = (float*)F.in[26]; if (PHM & 32768) norm_phase<3>(F, NL, true, F.out); PH_END }
#undef PH_BEGIN
#undef PH_END
}

#ifndef MK_SPLIT
#define MK_SPLIT 0
#endif
extern "C" void kernel_launch(void* const* d_in, const int* in_sizes, int n_in, void* d_out, int out_size, void* d_ws, size_t ws_size, hipStream_t stream) {
    static int grid = 0;
    if (grid == 0) {
        if (n_in != 26 || in_sizes[0] != T * DM || out_size != T * DM || ws_size < WS_END) {
            fprintf(stderr, "kernel_launch: unexpected problem (n_in %d, in0 %d, out %d, ws %zu < %zu); nothing launched\n", n_in, n_in > 0 ? in_sizes[0] : -1, out_size, ws_size, (size_t)WS_END); grid = -1; return; }
        int dev = 0, cus = 0, per_cu = 0;
        if (hipGetDevice(&dev) != hipSuccess || hipDeviceGetAttribute(&cus, hipDeviceAttributeMultiprocessorCount, dev) != hipSuccess) { grid = -1; return; }
        if (hipFuncSetAttribute((const void*)hybrid_fwd, hipFuncAttributeMaxDynamicSharedMemorySize, LDS_BYTES) != hipSuccess) { fprintf(stderr, "kernel_launch: hipFuncSetAttribute failed\n"); grid = -1; return; }
        if (hipOccupancyMaxActiveBlocksPerMultiprocessor(&per_cu, (const void*)hybrid_fwd, 512, LDS_BYTES) != hipSuccess || per_cu < 1) { fprintf(stderr, "kernel_launch: occupancy query says %d\n", per_cu); }
        (void)hipGetLastError();
        if (cus != 256) { fprintf(stderr, "kernel_launch: built for 256 CUs, device has %d; nothing launched\n", cus); grid = -1; return; }
        grid = 256;
    }
    if (grid < 0) return;
    if (hipMemsetAsync((char*)d_ws + WS_CTL, 0, CTL_BYTES, stream) != hipSuccess) return;
    Args a{};
    for (int i = 0; i < 26; ++i) a.in[i] = (const float*)d_in[i];
    a.out = (float*)d_out; a.ws = (unsigned char*)d_ws; a.pad = 0;
    constexpr int NPHASE = 64;
    if (MK_SPLIT == 0) { a.ph_lo = 0; a.ph_hi = NPHASE; a.li = 0; hipLaunchKernelGGL(hybrid_fwd, dim3(grid), dim3(512), LDS_BYTES, stream, a); }
    else { int li = 0; for (int p = 0; p < 48; p += MK_SPLIT, ++li) { a.ph_lo = p; a.ph_hi = p + MK_SPLIT; a.li = li; hipLaunchKernelGGL(hybrid_fwd, dim3(grid), dim3(512), LDS_BYTES, stream, a); } }
}
```

```cpp
#include <hip/hip_runtime.h>
#include <cstdio>
#include <cstdint>
#include <cmath>

#define GAS __attribute__((address_space(1)))
#define LAS __attribute__((address_space(3)))
typedef unsigned short bf16;
typedef short bf16x8 __attribute__((ext_vector_type(8)));
typedef float f32x4 __attribute__((ext_vector_type(4)));
typedef float f32x2 __attribute__((ext_vector_type(2)));
typedef float f32x16 __attribute__((ext_vector_type(16)));
typedef unsigned u32x4 __attribute__((ext_vector_type(4)));
typedef unsigned u32x2 __attribute__((ext_vector_type(2)));
typedef GAS unsigned gu32;

constexpr int NB = 4, SEQ = 8192, DM = 1024, NL = 4;
constexpr int T = NB * SEQ;
constexpr int HD = 64, NHF = 6, NHS = 6;
constexpr int PROJW = 2566;
constexpr int NQK = 1792;
constexpr int NVT = 768;
constexpr int SSMW = 256, SG = 16, NG = 16, NS = 64;
constexpr int DFF = 3584, NE = 8;
constexpr int CH = 64, NCH = SEQ / CH;
constexpr float EPS = 1e-6f;
constexpr float LOG2E = 1.4426950408889634f;
constexpr float QSCALE = 0.125f * LOG2E;
constexpr int MOE_TILES_MAX = 264, MOE_PASS_TILES = 132;

constexpr size_t MiB = 1u << 20;
constexpr size_t WS_CTL = 0, CTL_BYTES = 1 * MiB;
constexpr size_t WS_S5T = 1 * MiB;
constexpr size_t WS_WGLU = 2 * MiB;
constexpr size_t WS_LOGF = 3 * MiB;
constexpr size_t WS_C2 = 4 * MiB;
constexpr size_t WS_SEND = 5 * MiB;
constexpr size_t WS_RTE = 9 * MiB;
constexpr size_t WS_RTW = WS_RTE + 256 * 1024;
constexpr size_t WS_LRANK = WS_RTW + 256 * 1024;
constexpr size_t WS_TOKROW = WS_LRANK + 256 * 1024;
constexpr size_t WS_WGCNT = 10 * MiB;
constexpr size_t WS_MOEB = WS_WGCNT + 16384;
constexpr size_t WS_PTRS = WS_WGCNT + 32768;
constexpr size_t WS_WIN = 12 * MiB;
constexpr size_t WS_WOUT = 32 * MiB;
constexpr size_t WS_DGU = 40 * MiB;
constexpr size_t WS_DDN = 68 * MiB;
constexpr size_t WS_MGU = 82 * MiB;
constexpr size_t WS_MDN = 306 * MiB;
constexpr size_t WS_XN = 418 * MiB;
constexpr size_t WS_R1 = 482 * MiB;
constexpr size_t WS_FQ = WS_R1, WS_FK = WS_R1 + 24 * MiB, WS_SQ = WS_R1 + 48 * MiB, WS_SK = WS_R1 + 72 * MiB;
constexpr size_t WS_VT = WS_R1 + 96 * MiB;
constexpr size_t WS_SU = WS_R1 + 144 * MiB;
constexpr size_t WS_MIX = WS_R1 + 176 * MiB;
constexpr size_t WS_HID = WS_R1;
constexpr size_t WS_R2 = 722 * MiB;
constexpr size_t WS_END = 854 * MiB;
constexpr int CW_TMO = 0;
constexpr int CW_QHEAD = 64;
constexpr int CW_BAR = 4096;

constexpr int LDS_BYTES = 155648;
constexpr int LDS_CTL = 154624;
constexpr int RING_BYTES = 131072;

#define RLX_AGENT __ATOMIC_RELAXED, __HIP_MEMORY_SCOPE_AGENT
#define LDS_WAIT() asm volatile("s_waitcnt lgkmcnt(0)" ::: "memory")
__device__ __forceinline__ unsigned f2bf(float f) { unsigned u = __builtin_bit_cast(unsigned, f); return (u + 0x7fffu + ((u >> 16) & 1u)) >> 16; }
__device__ __forceinline__ unsigned pk2(float lo, float hi) { typedef __bf16 bf2 __attribute__((ext_vector_type(2))); f32x2 v = {lo, hi}; bf2 b = __builtin_convertvector(v, bf2); return __builtin_bit_cast(unsigned, b); }
__device__ __forceinline__ float bf2f(unsigned short h) { return __builtin_bit_cast(float, (unsigned)h << 16); }
__device__ __forceinline__ float wave_sum(float v) {
#pragma unroll
    for (int o = 1; o < 64; o <<= 1) v += __shfl_xor(v, o);
    return v;
}
__device__ __forceinline__ float wave_max(float v) {
#pragma unroll
    for (int o = 1; o < 64; o <<= 1) v = fmaxf(v, __shfl_xor(v, o));
    return v;
}
__device__ __forceinline__ float fexp2(float x) { return __builtin_amdgcn_exp2f(x); }
__device__ __forceinline__ float frcp(float x) { return __builtin_amdgcn_rcpf(x); }

namespace pg8 {
constexpr int BM = 256, BK = 64, HALF = 128, HTB = HALF * BK * 2, STAGE_BYTES = 8 * HTB, NXCD = 8, WGM = 8;
__host__ __device__ __forceinline__ int lds_byte(int r, int c) { const int st = (r >> 4) * 2 + (c >> 5), rr = r & 15, cc = c & 31, ob = rr * 64 + cc * 2; return st * 1024 + (ob ^ (((ob >> 9) & 1) << 5)); }
__host__ __device__ __forceinline__ void stage_rc(int b, int& R, int& C) { const int st = b / 1024, sb = b % 1024, swz = sb ^ (((sb >> 9) & 1) << 5); R = (st >> 1) * 16 + swz / 64; C = (st & 1) * 32 + (swz % 64) / 2; }
__host__ __device__ __forceinline__ int perm32(int rho) { const int n = rho >> 4, i = rho & 15; return 8 * (i >> 2) + 4 * n + (i & 3); }

struct Unit { int pm, pn, e; const char* A; const char* B; };

__device__ __forceinline__ bool tile_order(int i, int G, int c, int nM, int nN, int& pm, int& pn) {
    const int nwg = nM * nN; const long L = (long)i * G + c; if (L >= nwg) return false;
    int wgid = (int)L; { const int q = nwg / NXCD, r = nwg % NXCD, xcd = wgid % NXCD, off = wgid / NXCD; wgid = (xcd < r ? xcd * (q + 1) : r * (q + 1) + (xcd - r) * q) + off; }
    const int nig = WGM * nN, gid = wgid / nig, fm = gid * WGM, gsz = (nM - fm) < WGM ? (nM - fm) : WGM;
    pm = fm + ((wgid % nig) % gsz); pn = (wgid % nig) / gsz; return true;
}
constexpr int UNITS_OFF = 131072, UNITS_MAX = 64;
struct SchedLds {
    const LAS unsigned* list; int cnt;
    __device__ __forceinline__ bool next(int i, Unit& u) const {
        if (i >= cnt) return false;
        const u32x4 a = *(const LAS u32x4*)(list + 8 * i), b = *(const LAS u32x4*)(list + 8 * i + 4);
        u.pm = __builtin_amdgcn_readfirstlane((int)a.x); u.pn = __builtin_amdgcn_readfirstlane((int)a.y); u.e = __builtin_amdgcn_readfirstlane((int)a.z);
        const unsigned alo = __builtin_amdgcn_readfirstlane(b.x), ahi = __builtin_amdgcn_readfirstlane(b.y), blo = __builtin_amdgcn_readfirstlane(b.z), bhi = __builtin_amdgcn_readfirstlane(b.w);
        u.A = (const char*)(((unsigned long long)ahi << 32) | alo); u.B = (const char*)(((unsigned long long)bhi << 32) | blo); return true;
    }
};
__device__ __forceinline__ void put_unit(LAS unsigned* list, int i, int pm, int pn, int e, const char* A, const char* B) {
    const unsigned long long a = (unsigned long long)A, b = (unsigned long long)B;
    *(LAS u32x4*)(list + 8 * i) = (u32x4){(unsigned)pm, (unsigned)pn, (unsigned)e, 0u}; *(LAS u32x4*)(list + 8 * i + 4) = (u32x4){(unsigned)a, (unsigned)(a >> 32), (unsigned)b, (unsigned)(b >> 32)};
}
__device__ __forceinline__ SchedLds build_units_plain(LAS unsigned char* lds, int tid, int G, int c, int nM, int nN, const char* A0, const char* B0, size_t tstep) {
    LAS unsigned* list = (LAS unsigned*)(lds + UNITS_OFF);
    int pm, pn; int cnt = 0;
    if (tid < UNITS_MAX && tile_order(tid, G, c, nM, nN, pm, pn)) put_unit(list, tid, pm, pn, 0, A0 + (size_t)pm * tstep, B0 + (size_t)pn * tstep);
    { const int nwg = nM * nN; cnt = (c < nwg) ? (nwg - c + G - 1) / G : 0; }
    LDS_WAIT(); __syncthreads();
    return SchedLds{list, cnt};
}
__device__ __forceinline__ SchedLds build_units_moe(LAS unsigned char* lds, int tid, int G, int c, int nM, int nN, int tlo, const int* eb, const char* A0, const char* B0, size_t tstepA, size_t tstepB, size_t estride, bool a_local) {
    LAS unsigned* list = (LAS unsigned*)(lds + UNITS_OFF);
    int pm, pn; int cnt = 0;
    if (tid < UNITS_MAX && tile_order(tid, G, c, nM, nN, pm, pn)) {
        const int gp = tlo + pm; int e = 0;
        for (int j = 1; j < 8; ++j) e += (gp >= eb[j]) ? 1 : 0;
        put_unit(list, tid, gp, pn, e, A0 + (size_t)(a_local ? pm : gp) * tstepA, B0 + (size_t)e * estride + (size_t)pn * tstepB);
    }
    { const int nwg = nM * nN; cnt = (c < nwg) ? (nwg - c + G - 1) / G : 0; }
    LDS_WAIT(); __syncthreads();
    return SchedLds{list, cnt};
}

template <class Epi, class Sched, bool ALIGN_EPI, bool SP2>
__device__ __forceinline__ void gemm_phase(LAS unsigned char* lds, const int tid, const int K, const Sched& S, const Epi& E) {
    const int wid = __builtin_amdgcn_readfirstlane(tid >> 6), lane = tid & 63, wr = wid >> 2, wc = wid & 3, fr = lane & 15, fq = lane >> 4;
    const int nt = K / BK;
    unsigned voffA[2], voffB[2];
#pragma unroll
    for (int i = 0; i < 2; ++i) { int R, C; stage_rc(tid * 16 + i * 8192, R, C); const int Rb = Epi::PERM ? ((R & ~31) + perm32(R & 31)) : R;
        voffA[i] = (unsigned)(R * K + C) * 2u; voffB[i] = (unsigned)(Rb * K + C) * 2u; }
    const size_t kstep = (size_t)(BK * 2);
    const size_t hstep = (size_t)HALF * K * 2;
    const unsigned ldsw = (unsigned)wid * 1024u;
    const int aoff = lds_byte(wr * 64 + fr, fq * 8), boff = lds_byte(wc * 32 + fr, fq * 8);
#define PG8_SA(b, h) (((b) * 2 + (h)) * HTB)
#define PG8_SB(b, h) ((4 + (b) * 2 + (h)) * HTB)
#define PG8_STAGE(bufoff, gbase, voff) do { _Pragma("unroll") for (int _i = 0; _i < 2; ++_i) \
        __builtin_amdgcn_global_load_lds((const unsigned*)((const char*)(gbase) + (voff)[_i]), (LAS unsigned*)(lds + (bufoff) + ldsw + _i * 8192), 16, 0, 0); } while (0)
#define PG8_LDA(dst, b, h) do { _Pragma("unroll") for (int m = 0; m < 4; ++m) _Pragma("unroll") for (int k = 0; k < 2; ++k) dst[m][k] = *(const LAS bf16x8*)(lds + PG8_SA(b, h) + aoff + m * 2048 + k * 1024); } while (0)
#define PG8_LDB(dst, b, h) do { _Pragma("unroll") for (int n = 0; n < 2; ++n) _Pragma("unroll") for (int k = 0; k < 2; ++k) dst[n][k] = *(const LAS bf16x8*)(lds + PG8_SB(b, h) + boff + n * 2048 + k * 1024); } while (0)
#define PG8_MMA(ai, bj, At, Bt) do { __builtin_amdgcn_s_setprio(1); _Pragma("unroll") for (int m = 0; m < 4; ++m) _Pragma("unroll") for (int n = 0; n < 2; ++n) _Pragma("unroll") for (int k = 0; k < 2; ++k) \
        acc[ai][bj][m][n] = __builtin_amdgcn_mfma_f32_16x16x32_bf16(Bt[n][k], At[m][k], acc[ai][bj][m][n], 0, 0, 0); __builtin_amdgcn_s_setprio(0); } while (0)
#define PG8_WAIT_V(n) asm volatile("s_waitcnt vmcnt(" #n ")" ::: "memory")
#define PG8_WAIT_L(n) asm volatile("s_waitcnt lgkmcnt(" #n ")" ::: "memory")
#define PG8_BAR __builtin_amdgcn_s_barrier()
#define PG8_SCHED __builtin_amdgcn_sched_barrier(0)
    Unit cur, nxt; int ui = 0;
    if (!S.next(0, cur)) return;
    f32x4 acc[2][2][4][2];
#pragma unroll
    for (int a = 0; a < 2; ++a)
#pragma unroll
        for (int b = 0; b < 2; ++b)
#pragma unroll
            for (int m = 0; m < 4; ++m)
#pragma unroll
                for (int n = 0; n < 2; ++n) acc[a][b][m][n] = (f32x4){0.f, 0.f, 0.f, 0.f};
    bf16x8 At[4][2], B0[2][2], B1[2][2];
    const char* cA = cur.A; const char* cB = cur.B;
    if constexpr (SP2) {
        PG8_STAGE(PG8_SB(0, 0), cB, voffB); PG8_STAGE(PG8_SB(0, 1), cB + hstep, voffB); PG8_STAGE(PG8_SA(0, 0), cA, voffA); PG8_STAGE(PG8_SA(0, 1), cA + hstep, voffA);
        if (wr == 1) PG8_BAR;
        PG8_WAIT_V(2); PG8_BAR;
        PG8_STAGE(PG8_SB(1, 0), cB + kstep, voffB); PG8_STAGE(PG8_SA(1, 0), cA + kstep, voffA); PG8_STAGE(PG8_SB(1, 1), cB + hstep + kstep, voffB);
        PG8_WAIT_V(6); PG8_BAR;
    } else {
        PG8_STAGE(PG8_SB(0, 0), cB, voffB); PG8_STAGE(PG8_SA(0, 0), cA, voffA); PG8_STAGE(PG8_SB(0, 1), cB + hstep, voffB); PG8_STAGE(PG8_SA(0, 1), cA + hstep, voffA);
        if (wr == 1) PG8_BAR;
        PG8_WAIT_V(4); PG8_BAR;
        PG8_STAGE(PG8_SB(1, 0), cB + kstep, voffB); PG8_STAGE(PG8_SA(1, 0), cA + kstep, voffA); PG8_STAGE(PG8_SB(1, 1), cB + hstep + kstep, voffB);
        PG8_WAIT_V(6); PG8_BAR;
    }
    for (;;) {
        const bool has_next = S.next(ui + 1, nxt);
        const char* nA = has_next ? nxt.A : cA; const char* nB = has_next ? nxt.B : cB;
        for (int t = 0; t < nt; t += 2) {
            const bool last = (t == nt - 2);
            const char* a1 = cA + (size_t)(t + 1) * kstep;
            const char* a2 = last ? nA : cA + (size_t)(t + 2) * kstep; const char* b2 = last ? nB : cB + (size_t)(t + 2) * kstep;
            const char* a3 = a2 + kstep; const char* b3 = b2 + kstep;
            if constexpr (SP2) {
            PG8_LDB(B0, 0, 0); PG8_LDB(B1, 0, 1); PG8_SCHED; PG8_LDA(At, 0, 0); PG8_STAGE(PG8_SA(1, 1), a1 + hstep, voffA);
            PG8_WAIT_V(8); PG8_WAIT_L(0); PG8_BAR; PG8_MMA(0, 0, At, B0); PG8_MMA(0, 1, At, B1); PG8_BAR; PG8_SCHED;
            PG8_LDA(At, 0, 1); PG8_STAGE(PG8_SB(0, 0), b2, voffB); PG8_STAGE(PG8_SB(0, 1), b2 + hstep, voffB); PG8_STAGE(PG8_SA(0, 0), a2, voffA);
            PG8_WAIT_V(8); PG8_WAIT_L(0); PG8_BAR; PG8_MMA(1, 0, At, B0); PG8_MMA(1, 1, At, B1); PG8_BAR; PG8_SCHED;
            PG8_LDB(B0, 1, 0); PG8_LDB(B1, 1, 1); PG8_SCHED; PG8_LDA(At, 1, 0); PG8_STAGE(PG8_SA(0, 1), a2 + hstep, voffA);
            PG8_WAIT_V(8); PG8_WAIT_L(0); PG8_BAR; PG8_MMA(0, 0, At, B0); PG8_MMA(0, 1, At, B1); PG8_BAR; PG8_SCHED;
            PG8_LDA(At, 1, 1); PG8_STAGE(PG8_SB(1, 0), b3, voffB); PG8_STAGE(PG8_SB(1, 1), b3 + hstep, voffB); PG8_STAGE(PG8_SA(1, 0), a3, voffA);
            PG8_WAIT_V(8); PG8_WAIT_L(0); PG8_BAR; PG8_MMA(1, 0, At, B0); PG8_MMA(1, 1, At, B1); PG8_BAR; PG8_SCHED;
            } else {
            PG8_LDB(B0, 0, 0); PG8_SCHED; PG8_LDA(At, 0, 0); PG8_STAGE(PG8_SA(1, 1), a1 + hstep, voffA);
            PG8_WAIT_L(8); PG8_BAR; PG8_WAIT_L(0); PG8_MMA(0, 0, At, B0); PG8_BAR; PG8_SCHED;
            PG8_LDB(B1, 0, 1); PG8_STAGE(PG8_SB(0, 0), b2, voffB);
            PG8_BAR; PG8_WAIT_L(0); PG8_MMA(0, 1, At, B1); PG8_BAR;
            PG8_LDA(At, 0, 1); PG8_STAGE(PG8_SA(0, 0), a2, voffA);
            PG8_BAR; PG8_WAIT_L(0); PG8_MMA(1, 0, At, B0); PG8_BAR; PG8_SCHED;
            PG8_STAGE(PG8_SB(0, 1), b2 + hstep, voffB);
            PG8_WAIT_V(6); PG8_BAR; PG8_MMA(1, 1, At, B1); PG8_BAR;
            PG8_LDB(B0, 1, 0); PG8_SCHED; PG8_LDA(At, 1, 0); PG8_STAGE(PG8_SA(0, 1), a2 + hstep, voffA);
            PG8_WAIT_L(8); PG8_BAR; PG8_WAIT_L(0); PG8_MMA(0, 0, At, B0); PG8_BAR; PG8_SCHED;
            PG8_LDB(B1, 1, 1); PG8_STAGE(PG8_SB(1, 0), b3, voffB);
            PG8_BAR; PG8_WAIT_L(0); PG8_MMA(0, 1, At, B1); PG8_BAR;
            PG8_LDA(At, 1, 1); PG8_STAGE(PG8_SA(1, 0), a3, voffA);
            PG8_BAR; PG8_WAIT_L(0); PG8_MMA(1, 0, At, B0); PG8_BAR; PG8_SCHED;
            PG8_STAGE(PG8_SB(1, 1), b3 + hstep, voffB);
            PG8_WAIT_V(6); PG8_BAR; PG8_MMA(1, 1, At, B1); PG8_BAR;
            }
        }
        if constexpr (ALIGN_EPI) { if (wr == 0) PG8_BAR; }
        E(acc, cur, wr, wc, fr, fq);
        if (!has_next) break;
#pragma unroll
        for (int a = 0; a < 2; ++a)
#pragma unroll
            for (int b = 0; b < 2; ++b)
#pragma unroll
                for (int m = 0; m < 4; ++m)
#pragma unroll
                    for (int n = 0; n < 2; ++n) acc[a][b][m][n] = (f32x4){0.f, 0.f, 0.f, 0.f};
        cur = nxt; cA = nA; cB = nB; ++ui;
        if constexpr (ALIGN_EPI) { if (wr == 1) PG8_BAR; }
    }
    PG8_WAIT_V(0);
    if constexpr (!ALIGN_EPI) { if (wr == 0) PG8_BAR; }
    PG8_BAR;
#undef PG8_SA
#undef PG8_SB
#undef PG8_STAGE
#undef PG8_LDA
#undef PG8_LDB
#undef PG8_MMA
#undef PG8_WAIT_V
#undef PG8_WAIT_L
#undef PG8_BAR
#undef PG8_SCHED
}

typedef f32x4 Acc[2][2][4][2];

struct EpiProj {
    static constexpr bool PERM = true;
    bf16 *FQ, *FK, *SQ, *SK; float* SU; const float* qg; const float* kg;
    __device__ __forceinline__ void operator()(const Acc& acc, const Unit& u, int wr, int wc, int fr, int fq) const {
        const int g = 4 * u.pn + wc; const int row0 = u.pm * BM + wr * 64 + fr;
        if (g < 12) {
            const float* gp = (g < 6 ? qg : kg); const float sc = (g < 6) ? QSCALE : 1.f;
            bf16* dst = (g < 6 ? FQ + g * 64 : FK + (g - 6) * 64);
            f32x4 gv[2][2];
#pragma unroll
            for (int bj = 0; bj < 2; ++bj)
#pragma unroll
                for (int n = 0; n < 2; ++n) gv[bj][n] = *(const f32x4*)(gp + 32 * bj + 8 * fq + 4 * n) * sc;
#pragma unroll
            for (int ai = 0; ai < 2; ++ai)
#pragma unroll
                for (int m = 0; m < 4; ++m) {
                    float ss = 0.f;
#pragma unroll
                    for (int bj = 0; bj < 2; ++bj)
#pragma unroll
                        for (int n = 0; n < 2; ++n) { const f32x4 v = acc[ai][bj][m][n]; ss += (v[0] * v[0] + v[1] * v[1]) + (v[2] * v[2] + v[3] * v[3]); }
                    ss += __shfl_xor(ss, 16); ss += __shfl_xor(ss, 32);
                    const float r = __builtin_amdgcn_rsqf(ss * (1.f / 64.f) + EPS);
                    bf16* rowp = dst + (size_t)(row0 + ai * HALF + m * 16) * 384 + 8 * fq;
#pragma unroll
                    for (int bj = 0; bj < 2; ++bj) { const f32x4 v0 = acc[ai][bj][m][0] * r * gv[bj][0], v1 = acc[ai][bj][m][1] * r * gv[bj][1];
                        u32x4 w; w.x = pk2(v0[0], v0[1]); w.y = pk2(v0[2], v0[3]); w.z = pk2(v1[0], v1[1]); w.w = pk2(v1[2], v1[3]);
                        *(u32x4*)(rowp + 32 * bj) = w; }
                }
        } else if (g < 24) {
            const float sc = (g < 18) ? QSCALE : 1.f;
            bf16* dst = (g < 18 ? SQ + (g - 12) * 64 : SK + (g - 18) * 64);
#pragma unroll
            for (int ai = 0; ai < 2; ++ai)
#pragma unroll
                for (int m = 0; m < 4; ++m) { bf16* rowp = dst + (size_t)(row0 + ai * HALF + m * 16) * 384 + 8 * fq;
#pragma unroll
                    for (int bj = 0; bj < 2; ++bj) { const f32x4 v0 = acc[ai][bj][m][0] * sc, v1 = acc[ai][bj][m][1] * sc;
                        u32x4 w; w.x = pk2(v0[0], v0[1]); w.y = pk2(v0[2], v0[3]); w.z = pk2(v1[0], v1[1]); w.w = pk2(v1[2], v1[3]);
                        *(u32x4*)(rowp + 32 * bj) = w; } }
        } else {
            float* dst = SU + (g - 24) * 64;
#pragma unroll
            for (int ai = 0; ai < 2; ++ai)
#pragma unroll
                for (int m = 0; m < 4; ++m) { float* rowp = dst + (size_t)(row0 + ai * HALF + m * 16) * SSMW + 8 * fq;
#pragma unroll
                    for (int bj = 0; bj < 2; ++bj) { *(f32x4*)(rowp + 32 * bj) = acc[ai][bj][m][0]; *(f32x4*)(rowp + 32 * bj + 4) = acc[ai][bj][m][1]; } }
        }
    }
};
struct EpiStoreBf16 {
    static constexpr bool PERM = true;
    bf16* O; int ldc; int pm_off;
    __device__ __forceinline__ void operator()(const Acc& acc, const Unit& u, int wr, int wc, int fr, int fq) const {
        const int row0 = (u.pm - pm_off) * BM + wr * 64 + fr, col0 = u.pn * BM + wc * 32 + 8 * fq;
#pragma unroll
        for (int ai = 0; ai < 2; ++ai)
#pragma unroll
            for (int m = 0; m < 4; ++m) { bf16* rowp = O + (size_t)(row0 + ai * HALF + m * 16) * ldc + col0;
#pragma unroll
                for (int bj = 0; bj < 2; ++bj) { const f32x4 v0 = acc[ai][bj][m][0], v1 = acc[ai][bj][m][1];
                    u32x4 w; w.x = pk2(v0[0], v0[1]); w.y = pk2(v0[2], v0[3]); w.z = pk2(v1[0], v1[1]); w.w = pk2(v1[2], v1[3]);
                    *(u32x4*)(rowp + bj * HALF) = w; } }
    }
};
struct EpiResid {
    static constexpr bool PERM = false;
    const float* base; float* out;
    __device__ __forceinline__ void operator()(const Acc& acc, const Unit& u, int wr, int wc, int fr, int fq) const {
        const int row0 = u.pm * BM + wr * 64 + fr, col0 = u.pn * BM + wc * 32 + 4 * fq;
#pragma unroll
        for (int ai = 0; ai < 2; ++ai)
#pragma unroll
            for (int m = 0; m < 4; ++m) { const size_t off = (size_t)(row0 + ai * HALF + m * 16) * DM + col0;
#pragma unroll
                for (int bj = 0; bj < 2; ++bj)
#pragma unroll
                    for (int n = 0; n < 2; ++n) { const f32x4 b = *(const f32x4*)(base + off + bj * HALF + n * 16); *(f32x4*)(out + off + bj * HALF + n * 16) = b + acc[ai][bj][m][n]; } }
    }
};
struct EpiSwiglu {
    static constexpr bool PERM = true;
    bf16* Hd; int pm_off;
    __device__ __forceinline__ void operator()(const Acc& acc, const Unit& u, int wr, int wc, int fr, int fq) const {
        const int row0 = (u.pm - pm_off) * BM + wr * 64 + fr, col0 = u.pn * HALF + wc * 32 + 8 * fq;
#pragma unroll
        for (int ai = 0; ai < 2; ++ai)
#pragma unroll
            for (int m = 0; m < 4; ++m) { bf16* rowp = Hd + (size_t)(row0 + ai * HALF + m * 16) * DFF + col0;
                float h[8];
#pragma unroll
                for (int n = 0; n < 2; ++n)
#pragma unroll
                    for (int i = 0; i < 4; ++i) { const float a = acc[ai][0][m][n][i], b = acc[ai][1][m][n][i]; h[4 * n + i] = a * frcp(1.f + fexp2(-a * LOG2E)) * b; }
                u32x4 w; w.x = pk2(h[0], h[1]); w.y = pk2(h[2], h[3]); w.z = pk2(h[4], h[5]); w.w = pk2(h[6], h[7]);
                *(u32x4*)rowp = w; }
    }
};
}

#define XB_TMO      128
#define XB_XCNT(j)  (256  + 64 * (j))
#define XB_XSUB(j)  (1280 + 64 * (j))
#define XB_XGEN(j)  (2304 + 64 * (j))
#define XB_TOP      3328
#define XB_TOPGEN   3392
#define XCD_BAR_WORDS 3456
#define XB_SPIN_CAP (1u << 18)
__device__ __forceinline__ unsigned xb_ld(unsigned* p)              { return __hip_atomic_load(p, __ATOMIC_RELAXED, __HIP_MEMORY_SCOPE_AGENT); }
__device__ __forceinline__ unsigned xb_add(unsigned* p, unsigned v) { return __hip_atomic_fetch_add(p, v, __ATOMIC_RELAXED, __HIP_MEMORY_SCOPE_AGENT); }
__device__ __forceinline__ unsigned xb_xcc_id() { return (unsigned)__builtin_amdgcn_s_getreg((3 << 11) | 20) & 0xFu; }
#define XB_SPIN(cond, bar) do { unsigned _sp = 0; while (cond) { __builtin_amdgcn_s_sleep(1); \
    if ((++_sp & 255u) == 0u) { if (xb_ld(&(bar)[XB_TMO])) break; if (_sp > XB_SPIN_CAP) { atomicAdd(&(bar)[XB_TMO], 1u); break; } } } } while (0)
struct XcdBarrier { unsigned* bar; unsigned x; volatile LAS unsigned* st; };
__device__ __forceinline__ XcdBarrier xcd_barrier_post(unsigned* bar, volatile LAS unsigned* st) {
    XcdBarrier b; b.bar = bar; b.x = xb_xcc_id(); b.st = st;
    if (threadIdx.x == 0) (void)xb_add(&bar[XB_XCNT(b.x)], 1u);
    return b;
}
__device__ __forceinline__ void xcd_barrier_complete(unsigned* bar, unsigned x, unsigned& nloc, unsigned& nx) {
    const unsigned G = gridDim.x * gridDim.y * gridDim.z;
    unsigned sum, cnt, mine, sp = 0u;
    for (;;) {
        sum = 0u; cnt = 0u; mine = 0u;
#pragma unroll
        for (unsigned j = 0; j < 16; ++j) { const unsigned c = xb_ld(&bar[XB_XCNT(j)]); sum += c; cnt += (c > 0u) ? 1u : 0u; mine = (j == x) ? c : mine; }
        if (sum == G) break;
        __builtin_amdgcn_s_sleep(1);
        if ((++sp & 255u) == 0u) { if (xb_ld(&bar[XB_TMO])) break; if (sp > XB_SPIN_CAP) { atomicAdd(&bar[XB_TMO], 1u); break; } }
    }
    nloc = mine > 0u ? mine : 1u; nx = cnt > 0u ? cnt : 1u;
}
__device__ __forceinline__ void xcd_barrier(const XcdBarrier& b) {
    asm volatile("s_waitcnt vmcnt(0)" ::: "memory");
    __syncthreads();
    if (threadIdx.x == 0) {
        unsigned* bar = b.bar;
        __builtin_amdgcn_s_waitcnt(0);
        unsigned nloc = b.st[0], nx = b.st[1];
        if (nloc == 0u) { xcd_barrier_complete(bar, b.x, nloc, nx); b.st[0] = nloc; b.st[1] = nx; }
        const unsigned old = xb_add(&bar[XB_XSUB(b.x)], 1u);
        const unsigned gen = old / nloc;
        if (old + 1u == (gen + 1u) * nloc) {
            __builtin_amdgcn_fence(__ATOMIC_RELEASE, "agent");
            asm volatile("s_waitcnt vmcnt(0)" ::: "memory");
            const unsigned og = xb_add(&bar[XB_TOP], 1u);
            const unsigned tg = og / nx;
            if (og + 1u == (tg + 1u) * nx) xb_add(&bar[XB_TOPGEN], 1u);
            else XB_SPIN(xb_ld(&bar[XB_TOPGEN]) == tg, bar);
            __builtin_amdgcn_fence(__ATOMIC_ACQUIRE, "agent");
            xb_add(&bar[XB_XGEN(b.x)], 1u);
            asm volatile("s_waitcnt vmcnt(0)" ::: "memory");
        } else {
            XB_SPIN(xb_ld(&bar[XB_XGEN(b.x)]) == gen, bar);
            __builtin_amdgcn_fence(__ATOMIC_ACQUIRE, "agent");
            asm volatile("s_waitcnt vmcnt(0)" ::: "memory");
        }
    }
    __syncthreads();
}

struct Args { const float* in[26]; float* out; unsigned char* ws; int ph_lo, ph_hi, li, pad; };
struct Frame {
    LAS unsigned char* lds;
    gu32* ctl;
    int tid, lane, wave, vcu, G;
    const float* const* in;
    unsigned char* ws; float* out;
};
#define IN_X 0
#define IN_ATTN_NORM 1
#define IN_FFN_NORM 2
#define IN_W_IN 3
#define IN_B_FORGET 4
#define IN_FQN 5
#define IN_FKN 6
#define IN_A_RE 7
#define IN_A_IM 8
#define IN_LOG_DT 9
#define IN_B_RE 10
#define IN_B_IM 11
#define IN_C_RE 12
#define IN_C_IM 13
#define IN_SSM_D 14
#define IN_W_GLU 15
#define IN_B_GLU 16
#define IN_OUT_NORM 17
#define IN_W_OUT 18
#define IN_DGATE 19
#define IN_DUP 20
#define IN_DDOWN 21
#define IN_ROUTER 22
#define IN_MGATE 23
#define IN_MUP 24
#define IN_MDOWN 25

__device__ __forceinline__ int map_row(int kind, int n) {
    if (kind == 0) return n;
    if (kind == 2) return 256 * (n >> 7) + (n & 127);
    if (kind == 3) return 256 * (n >> 7) + 128 + (n & 127);
    int j;
    if (n < 768) j = n;
    else if (n < 1152) return NQK + (n - 768);
    else if (n < 1158) return -1;
    else if (n < 1542) j = 768 + (n - 1158);
    else if (n < 1926) j = 1152 + (n - 1542);
    else if (n < 2310) return NQK + 384 + (n - 1926);
    else j = 1536 + (n - 2310);
    return (j & ~255) + 128 * ((j >> 5) & 1) + 32 * ((j >> 6) & 3) + (j & 31);
}
__device__ __forceinline__ void tr_item(const float* W, int K, int N, bf16* WT, int kind, LAS float* scr, int item, int lane) {
    const int nblk = (N + 31) >> 5, kb = item / nblk, nb = item - kb * nblk, k0 = 64 * kb, n0 = 32 * nb;
    const int nn = n0 + (lane & 31);
    float tv[32];
#pragma unroll
    for (int i = 0; i < 32; ++i) { const int kk = 2 * i + (lane >> 5); tv[i] = (nn < N) ? *(const GAS float*)(W + (size_t)(k0 + kk) * N + nn) : 0.f; }
#pragma unroll
    for (int i = 0; i < 32; ++i) { const int kk = 2 * i + (lane >> 5); scr[kk * 33 + (lane & 31)] = tv[i]; }
    LDS_WAIT(); asm volatile("" ::: "memory");
    const int c = lane & 7;
#pragma unroll
    for (int j = 0; j < 4; ++j) { const int nl = (lane >> 3) + 8 * j; const int n = n0 + nl; const LAS float* s = scr + (8 * c) * 33 + nl;
        const int dr = (n < N) ? map_row(kind, n) : -1;
        if (dr >= 0) { u32x4 o; o.x = pk2(s[0 * 33], s[1 * 33]); o.y = pk2(s[2 * 33], s[3 * 33]); o.z = pk2(s[4 * 33], s[5 * 33]); o.w = pk2(s[6 * 33], s[7 * 33]);
            *(u32x4*)(WT + (size_t)dr * K + k0 + 8 * c) = o; } }
    LDS_WAIT(); asm volatile("" ::: "memory");
}
__device__ __forceinline__ void p0_prologue(const Frame& F, const Args& A) {
    if (blockIdx.x == 0 && F.tid < 27) ((const void**)(F.ws + WS_PTRS))[F.tid] = (F.tid < 26) ? (const void*)A.in[F.tid] : (const void*)A.out;
    LAS float* scr = (LAS float*)(F.lds + F.wave * 16384);
    const int gw = F.vcu * 8 + F.wave, NGW = F.G * 8;
    unsigned char* ws = F.ws;
    constexpr int I_IN = 16 * 81, I_OUT = 16 * 32, I_GLU = 4 * 8, I_FF = 1792;
    constexpr int S0 = NL * I_IN, S1 = S0 + NL * I_OUT, S2 = S1 + NL * I_GLU, S3 = S2 + 2 * I_FF  , S4 = S3 + 2 * I_FF  , S5 = S4 + 2 * I_FF  ,
                  S6 = S5 + 16 * I_FF  , S7 = S6 + 16 * I_FF  , S8 = S7 + 16 * I_FF  ;
    for (int it = gw; it < S8; it += NGW) {
        if (it < S0) { const int l = it / I_IN, r = it - l * I_IN; tr_item(A.in[IN_W_IN] + (size_t)l * DM * PROJW, DM, PROJW, (bf16*)(ws + WS_WIN) + (size_t)l * 2560 * DM, 1, scr, r, F.lane); }
        else if (it < S1) { const int q = it - S0, l = q / I_OUT, r = q - l * I_OUT; tr_item(A.in[IN_W_OUT] + (size_t)l * DM * DM, DM, DM, (bf16*)(ws + WS_WOUT) + (size_t)l * DM * DM, 0, scr, r, F.lane); }
        else if (it < S2) { const int q = it - S1, l = q / I_GLU, r = q - l * I_GLU; tr_item(A.in[IN_W_GLU] + (size_t)l * 65536, 256, 256, (bf16*)(ws + WS_WGLU) + (size_t)l * 65536, 0, scr, r, F.lane); }
        else if (it < S3) { const int q = it - S2, l = q / I_FF, r = q - l * I_FF; tr_item(A.in[IN_DGATE] + (size_t)l * DM * DFF, DM, DFF, (bf16*)(ws + WS_DGU) + (size_t)l * 7168 * DM, 2, scr, r, F.lane); }
        else if (it < S4) { const int q = it - S3, l = q / I_FF, r = q - l * I_FF; tr_item(A.in[IN_DUP] + (size_t)l * DM * DFF, DM, DFF, (bf16*)(ws + WS_DGU) + (size_t)l * 7168 * DM, 3, scr, r, F.lane); }
        else if (it < S5) { const int q = it - S4, l = q / I_FF, r = q - l * I_FF; tr_item(A.in[IN_DDOWN] + (size_t)l * DFF * DM, DFF, DM, (bf16*)(ws + WS_DDN) + (size_t)l * DM * DFF, 0, scr, r, F.lane); }
        else if (it < S6) { const int q = it - S5, l = q / I_FF, r = q - l * I_FF; tr_item(A.in[IN_MGATE] + (size_t)l * DM * DFF, DM, DFF, (bf16*)(ws + WS_MGU) + (size_t)l * 7168 * DM, 2, scr, r, F.lane); }
        else if (it < S7) { const int q = it - S6, l = q / I_FF, r = q - l * I_FF; tr_item(A.in[IN_MUP] + (size_t)l * DM * DFF, DM, DFF, (bf16*)(ws + WS_MGU) + (size_t)l * 7168 * DM, 3, scr, r, F.lane); }
        else { const int q = it - S7, l = q / I_FF, r = q - l * I_FF; tr_item(A.in[IN_MDOWN] + (size_t)l * DFF * DM, DFF, DM, (bf16*)(ws + WS_MDN) + (size_t)l * DM * DFF, 0, scr, r, F.lane); }
    }
    const int gt = F.vcu * 512 + F.tid;
    if (gt < NL * NG * NS) {
        const int n = gt & 63, lg = gt >> 6, g = lg & 15;
        const double are = (double)A.in[IN_A_RE][gt], aim = (double)A.in[IN_A_IM][gt];
        const double dt = exp((double)A.in[IN_LOG_DT][lg]);
        const double mag = exp(dt * are), ang = dt * aim;
        const double abr = mag * cos(ang), abi = mag * sin(ang);
        const double magL = exp((double)CH * dt * are), angL = (double)CH * ang;
        const double den = are * are + aim * aim, nr = abr - 1.0, ni = abi;
        const double cr = (nr * are + ni * aim) / den, ci = (ni * are - nr * aim) / den;
        float* tb = (float*)(ws + WS_S5T) + (size_t)lg * 2304;
        tb[n] = (float)abr; tb[64 + n] = (float)abi; tb[128 + n] = (float)(magL * cos(angL)); tb[192 + n] = (float)(magL * sin(angL));
        const float* bre = A.in[IN_B_RE] + (size_t)gt * SG; const float* bim = A.in[IN_B_IM] + (size_t)gt * SG;
        (void)g;
#pragma unroll
        for (int c = 0; c < SG; ++c) { const double br = bre[c], bi = bim[c]; tb[256 + n * 16 + c] = (float)(cr * br - ci * bi); tb[1280 + n * 16 + c] = (float)(cr * bi + ci * br); }
    }
}

template <int MODE>
__device__ __forceinline__ void norm_phase(const Frame& F, int layer, bool combine, const float* xsrc) {
    unsigned char* ws = F.ws;
    LAS float* wl = (LAS float*)F.lds;
    LAS int* rte = (LAS int*)(F.lds + 32768);
    if (MODE == 0) { const float* w = F.in[IN_W_IN] + (size_t)layer * DM * PROJW + 1152;
        for (int idx = F.tid; idx < 6 * DM; idx += 512) { const int k = idx / 6, h = idx - 6 * k; wl[h * DM + k] = w[(size_t)k * PROJW + h]; } }
    if (MODE == 2) { const float* w = F.in[IN_ROUTER] + (size_t)(layer >> 1) * DM * NE;
        for (int idx = F.tid; idx < NE * DM; idx += 512) { const int k = idx >> 3, e = idx & 7; wl[e * DM + k] = w[idx]; } }
    if (MODE == 0 || MODE == 2) __syncthreads();
    const float* gain = (MODE == 0 ? F.in[IN_ATTN_NORM] : F.in[IN_FFN_NORM]) + layer * DM;
    f32x4 gv[4];
    if (MODE != 3) {
#pragma unroll
        for (int j = 0; j < 4; ++j) gv[j] = *(const f32x4*)(gain + 4 * F.lane + 256 * j);
    }
    const bf16* Y = (const bf16*)(ws + WS_R2);
    for (int i = 0; i < 16; ++i) {
        const int li = F.wave + 8 * i, tok = 128 * F.vcu + li;
        f32x4 v[4];
#pragma unroll
        for (int j = 0; j < 4; ++j) v[j] = *(const f32x4*)(xsrc + (size_t)tok * DM + 4 * F.lane + 256 * j);
        if (combine) {
            const int2 tr = *(const int2*)(ws + WS_TOKROW + (size_t)tok * 8); const f32x2 rw = *(const f32x2*)(ws + WS_RTW + (size_t)tok * 8);
#pragma unroll
            for (int j = 0; j < 4; ++j) {
                const u32x2 a = *(const u32x2*)(Y + (size_t)tr.x * DM + 4 * F.lane + 256 * j), b = *(const u32x2*)(Y + (size_t)tr.y * DM + 4 * F.lane + 256 * j);
                v[j][0] += rw.x * bf2f((unsigned short)(a.x & 0xffff)) + rw.y * bf2f((unsigned short)(b.x & 0xffff));
                v[j][1] += rw.x * bf2f((unsigned short)(a.x >> 16)) + rw.y * bf2f((unsigned short)(b.x >> 16));
                v[j][2] += rw.x * bf2f((unsigned short)(a.y & 0xffff)) + rw.y * bf2f((unsigned short)(b.y & 0xffff));
                v[j][3] += rw.x * bf2f((unsigned short)(a.y >> 16)) + rw.y * bf2f((unsigned short)(b.y >> 16));
                *(f32x4*)(F.out + (size_t)tok * DM + 4 * F.lane + 256 * j) = v[j];
            }
        }
        if (MODE == 3) continue;
        float ss = 0.f;
#pragma unroll
        for (int j = 0; j < 4; ++j) ss += (v[j][0] * v[j][0] + v[j][1] * v[j][1]) + (v[j][2] * v[j][2] + v[j][3] * v[j][3]);
        const float r = __builtin_amdgcn_rsqf(wave_sum(ss) * (1.f / DM) + EPS);
        bf16* xn = (bf16*)(ws + WS_XN) + (size_t)tok * DM;
#pragma unroll
        for (int j = 0; j < 4; ++j) { v[j] = v[j] * r * gv[j]; u32x2 w; w.x = pk2(v[j][0], v[j][1]); w.y = pk2(v[j][2], v[j][3]); *(u32x2*)(xn + 4 * F.lane + 256 * j) = w; }
        if (MODE == 0) {
            float fg[6];
#pragma unroll
            for (int h = 0; h < 6; ++h) { float s = 0.f;
#pragma unroll
                for (int j = 0; j < 4; ++j) { const f32x4 w = *(const LAS f32x4*)(wl + h * DM + 4 * F.lane + 256 * j); s += (v[j][0] * w[0] + v[j][1] * w[1]) + (v[j][2] * w[2] + v[j][3] * w[3]); }
                fg[h] = wave_sum(s); }
            if (F.lane < 6) {
                float x = fg[0];
#pragma unroll
                for (int h = 1; h < 6; ++h) x = (F.lane == h) ? fg[h] : x;
                x += F.in[IN_B_FORGET][layer * 6 + F.lane];
                const float lf = fminf(x, 0.f) - log1pf(expf(-fabsf(x)));
                const int b = tok / SEQ, s = tok - b * SEQ;
                ((float*)(ws + WS_LOGF))[(size_t)(b * 6 + F.lane) * SEQ + s] = lf;
            }
        }
        if (MODE == 2) {
            float lg[8];
#pragma unroll
            for (int e = 0; e < 8; ++e) { float s = 0.f;
#pragma unroll
                for (int j = 0; j < 4; ++j) { const f32x4 w = *(const LAS f32x4*)(wl + e * DM + 4 * F.lane + 256 * j); s += (v[j][0] * w[0] + v[j][1] * w[1]) + (v[j][2] * w[2] + v[j][3] * w[3]); }
                lg[e] = wave_sum(s); }
            int e1 = 0; float v1 = lg[0];
#pragma unroll
            for (int e = 1; e < 8; ++e) if (lg[e] > v1) { v1 = lg[e]; e1 = e; }
            int e2 = -1; float v2 = -INFINITY;
#pragma unroll
            for (int e = 0; e < 8; ++e) if (e != e1 && lg[e] > v2) { v2 = lg[e]; e2 = e; }
            const float w1 = 1.f / (1.f + expf(v2 - v1));
            if (F.lane == 0) { *(int2*)(ws + WS_RTE + (size_t)tok * 8) = make_int2(e1, e2); *(f32x2*)(ws + WS_RTW + (size_t)tok * 8) = (f32x2){w1, 1.f - w1}; rte[2 * li] = e1; rte[2 * li + 1] = e2; }
        }
    }
    if (MODE == 2) {
        __syncthreads();
        if (F.wave == 0) {
            const int a1 = rte[2 * F.lane], a2 = rte[2 * F.lane + 1], b1 = rte[2 * (64 + F.lane)], b2 = rte[2 * (64 + F.lane) + 1];
            const unsigned long long lt = (1ull << F.lane) - 1ull;
            int ra1 = 0, ra2 = 0, rb1 = 0, rb2 = 0, mycnt = 0;
#pragma unroll
            for (int e = 0; e < 8; ++e) {
                const unsigned long long m0 = __ballot(a1 == e || a2 == e), m1 = __ballot(b1 == e || b2 == e);
                const int r0 = __popcll(m0 & lt), r1 = __popcll(m0) + __popcll(m1 & lt);
                if (a1 == e) ra1 = r0; if (a2 == e) ra2 = r0; if (b1 == e) rb1 = r1; if (b2 == e) rb2 = r1;
                if (F.lane == e) mycnt = __popcll(m0) + __popcll(m1);
            }
            *(int2*)(ws + WS_LRANK + (size_t)(128 * F.vcu + F.lane) * 8) = make_int2(ra1, ra2);
            *(int2*)(ws + WS_LRANK + (size_t)(128 * F.vcu + 64 + F.lane) * 8) = make_int2(rb1, rb2);
            if (F.lane < 8) ((int*)(ws + WS_WGCNT))[F.vcu * 8 + F.lane] = mycnt;
        }
    }
}

__device__ __forceinline__ void moe_gather_phase(const Frame& F) {
    unsigned char* ws = F.ws;
    LAS int* sh = (LAS int*)F.lds;
    const int* wc = (const int*)(ws + WS_WGCNT);
    {
        const int e = F.wave; int tot = 0, pre = 0;
#pragma unroll
        for (int j = 0; j < 4; ++j) { const int w = F.lane + 64 * j; const int c = wc[w * 8 + e]; tot += c; pre += (w < F.vcu) ? c : 0; }
#pragma unroll
        for (int o = 1; o < 64; o <<= 1) { tot += __shfl_xor(tot, o); pre += __shfl_xor(pre, o); }
        if (F.lane == 0) { sh[e] = tot; sh[8 + e] = pre; }
    }
    __syncthreads();
    if (F.tid == 0) { int b = 0; for (int e = 0; e < 8; ++e) { sh[16 + e] = b; b += (sh[e] + 255) & ~255; } sh[24] = b;
        if (F.vcu == 0) { int* mb = (int*)(ws + WS_MOEB); for (int e = 0; e < 9; ++e) mb[e] = sh[16 + e] >> 8; } }
    __syncthreads();
    const bf16* XN = (const bf16*)(ws + WS_XN); bf16* AG = (bf16*)(ws + WS_R2);
    for (int i = 0; i < 16; ++i) {
        const int tok = 128 * F.vcu + F.wave + 8 * i;
        const int2 ee = *(const int2*)(ws + WS_RTE + (size_t)tok * 8), rk = *(const int2*)(ws + WS_LRANK + (size_t)tok * 8);
        const int r1 = sh[16 + ee.x] + sh[8 + ee.x] + rk.x, r2 = sh[16 + ee.y] + sh[8 + ee.y] + rk.y;
        const u32x4* src = (const u32x4*)(XN + (size_t)tok * DM);
        const u32x4 a = src[F.lane], b = src[64 + F.lane];
        u32x4* d1 = (u32x4*)(AG + (size_t)r1 * DM); u32x4* d2 = (u32x4*)(AG + (size_t)r2 * DM);
        d1[F.lane] = a; d1[64 + F.lane] = b; d2[F.lane] = a; d2[64 + F.lane] = b;
        if (F.lane == 0) *(int2*)(ws + WS_TOKROW + (size_t)tok * 8) = make_int2(r1, r2);
    }
}

__device__ __forceinline__ void cumsum_phase(const Frame& F) {
    if (F.vcu >= 24) return;
    unsigned char* ws = F.ws;
    LAS float* sh = (LAS float*)F.lds;
    const float* lf = (const float*)(ws + WS_LOGF) + (size_t)F.vcu * SEQ + 16 * F.tid;
    float v[16];
#pragma unroll
    for (int j = 0; j < 4; ++j) { const f32x4 x = *(const f32x4*)(lf + 4 * j); v[4 * j] = x[0]; v[4 * j + 1] = x[1]; v[4 * j + 2] = x[2]; v[4 * j + 3] = x[3]; }
#pragma unroll
    for (int j = 1; j < 16; ++j) v[j] += v[j - 1];
    float run = v[15];
#pragma unroll
    for (int o = 1; o < 64; o <<= 1) { const float t = __shfl_up(run, o); if (F.lane >= o) run += t; }
    if (F.lane == 63) sh[F.wave] = run;
    __syncthreads();
    float base = run - v[15];
    for (int w = 0; w < F.wave; ++w) base += sh[w];
    float* c2 = (float*)(ws + WS_C2) + (size_t)F.vcu * SEQ + 16 * F.tid;
#pragma unroll
    for (int j = 0; j < 4; ++j) *(f32x4*)(c2 + 4 * j) = (f32x4){(base + v[4 * j]) * LOG2E, (base + v[4 * j + 1]) * LOG2E, (base + v[4 * j + 2]) * LOG2E, (base + v[4 * j + 3]) * LOG2E};
    __syncthreads();
}

__device__ __forceinline__ bf16x8 pack8(const f32x16& p, int s) {
    u32x4 w; w.x = pk2(p[8 * s], p[8 * s + 1]); w.y = pk2(p[8 * s + 2], p[8 * s + 3]); w.z = pk2(p[8 * s + 4], p[8 * s + 5]); w.w = pk2(p[8 * s + 6], p[8 * s + 7]);
    return __builtin_bit_cast(bf16x8, w);
}
__device__ __forceinline__ float sumsq8(bf16x8 v) { float s = 0.f;
#pragma unroll
    for (int j = 0; j < 8; ++j) { const float f = bf2f((unsigned short)v[j]); s += f * f; } return s; }

template <bool FOX>
__device__ __forceinline__ void attn_item(const Frame& F, int layer, int b, int h, int qb, float kbound) {
    unsigned char* ws = F.ws;
    const int lane = F.lane, q = lane & 31, hh = lane >> 5;
    const size_t tok0 = (size_t)b * SEQ; const int q0 = qb * 32, qa = q0 + q;
    const bf16* Qb = (const bf16*)(ws + (FOX ? WS_FQ : WS_SQ)); const bf16* Kb = (const bf16*)(ws + (FOX ? WS_FK : WS_SK));
    const bf16* Vt = (const bf16*)(ws + WS_VT) + (size_t)((FOX ? 0 : 384) + h * 64) * T;
    bf16x8 qf[4];
#pragma unroll
    for (int ks = 0; ks < 4; ++ks) qf[ks] = *(const bf16x8*)(Qb + (tok0 + qa) * 384 + h * 64 + 16 * ks + 8 * hh);
    const int krow = 32 * ((q >> 2) & 1) + 8 * (q >> 4) + 4 * ((q >> 3) & 1) + (q & 3);
    const bf16* Kp = Kb + (tok0 + krow) * 384 + h * 64 + 8 * hh;
    const bf16* Vp = Vt + (size_t)q * T + tok0 + 32 * hh;
    const float* c2 = (const float*)(ws + WS_C2) + (size_t)(b * 6 + h) * SEQ;
    float ct = 0.f, qk = 0.f;
    if (FOX) { ct = c2[qa]; float qs = sumsq8(qf[0]) + sumsq8(qf[1]) + sumsq8(qf[2]) + sumsq8(qf[3]); qs += __shfl_xor(qs, 32); qk = sqrtf(qs) * kbound; }
    float m = -INFINITY, l = 0.f, carry = 1.f;
    f32x16 o0, o1;
#pragma unroll
    for (int r = 0; r < 16; ++r) { o0[r] = 0.f; o1[r] = 0.f; }
    const int ktd = q0 >> 6;
    for (int kt = ktd; kt >= 0; --kt) {
        bf16x8 kf[2][4];
#pragma unroll
        for (int blk = 0; blk < 2; ++blk)
#pragma unroll
            for (int ks = 0; ks < 4; ++ks) kf[blk][ks] = *(const bf16x8*)(Kp + (size_t)(64 * kt + 16 * blk) * 384 + 16 * ks);
        bf16x8 vf[2][2][2];
#pragma unroll
        for (int db = 0; db < 2; ++db)
#pragma unroll
            for (int blk = 0; blk < 2; ++blk)
#pragma unroll
                for (int s = 0; s < 2; ++s) vf[db][blk][s] = *(const bf16x8*)(Vp + (size_t)(32 * db) * T + 64 * kt + 16 * blk + 8 * s);
        f32x16 p0, p1;
#pragma unroll
        for (int r = 0; r < 16; ++r) { p0[r] = 0.f; p1[r] = 0.f; }
#pragma unroll
        for (int ks = 0; ks < 4; ++ks) { p0 = __builtin_amdgcn_mfma_f32_32x32x16_bf16(kf[0][ks], qf[ks], p0, 0, 0, 0); p1 = __builtin_amdgcn_mfma_f32_32x32x16_bf16(kf[1][ks], qf[ks], p1, 0, 0, 0); }
        const int kbase = 64 * kt + 32 * hh;
        if (FOX) {
            const float* cp = c2 + kbase;
#pragma unroll
            for (int j = 0; j < 4; ++j) { const f32x4 ca = *(const f32x4*)(cp + 4 * j), cb = *(const f32x4*)(cp + 16 + 4 * j);
#pragma unroll
                for (int i = 0; i < 4; ++i) { p0[4 * j + i] += ct - ca[i]; p1[4 * j + i] += ct - cb[i]; } }
            if (kt == ktd) {
#pragma unroll
                for (int r = 0; r < 16; ++r) { if (kbase + r > qa) p0[r] = -INFINITY; if (kbase + 16 + r > qa) p1[r] = -INFINITY; }
            }
            float tm = fmaxf(p0[0], p1[0]);
#pragma unroll
            for (int r = 1; r < 16; ++r) tm = fmaxf(tm, fmaxf(p0[r], p1[r]));
            tm = fmaxf(tm, __shfl_xor(tm, 32));
            const float mn = fmaxf(m, tm), alpha = fexp2(m - mn);
            float ls = 0.f;
#pragma unroll
            for (int r = 0; r < 16; ++r) { p0[r] = fexp2(p0[r] - mn); p1[r] = fexp2(p1[r] - mn); ls += p0[r] + p1[r]; }
            l = l * alpha + ls; m = mn;
#pragma unroll
            for (int r = 0; r < 16; ++r) { o0[r] *= alpha; o1[r] *= alpha; }
        } else {
            float om[32];
            const bool diag = (kt == ktd);
#pragma unroll
            for (int r = 0; r < 16; ++r) {
                { const float e = fexp2(fminf(p0[r], 80.f)); float t = frcp(1.f + e); float bt = e * t; if (diag && kbase + r >= qa) { bt = 0.f; t = 1.f; } p0[r] = bt; om[r] = t; }
                { const float e = fexp2(fminf(p1[r], 80.f)); float t = frcp(1.f + e); float bt = e * t; if (diag && kbase + 16 + r >= qa) { bt = 0.f; t = 1.f; } p1[r] = bt; om[16 + r] = t; }
            }
            float run = 1.f;
#pragma unroll
            for (int r = 15; r >= 0; --r) { p1[r] *= run; run *= om[16 + r]; }
#pragma unroll
            for (int r = 15; r >= 0; --r) { p0[r] *= run; run *= om[r]; }
            const float other = __shfl_xor(run, 32);
            const float lc = carry * (hh == 0 ? other : 1.f);
#pragma unroll
            for (int r = 0; r < 16; ++r) { p0[r] *= lc; p1[r] *= lc; }
            carry *= run * other;
        }
        const bf16x8 pb00 = pack8(p0, 0), pb01 = pack8(p0, 1), pb10 = pack8(p1, 0), pb11 = pack8(p1, 1);
        o0 = __builtin_amdgcn_mfma_f32_32x32x16_bf16(vf[0][0][0], pb00, o0, 0, 0, 0); o0 = __builtin_amdgcn_mfma_f32_32x32x16_bf16(vf[0][0][1], pb01, o0, 0, 0, 0);
        o0 = __builtin_amdgcn_mfma_f32_32x32x16_bf16(vf[0][1][0], pb10, o0, 0, 0, 0); o0 = __builtin_amdgcn_mfma_f32_32x32x16_bf16(vf[0][1][1], pb11, o0, 0, 0, 0);
        o1 = __builtin_amdgcn_mfma_f32_32x32x16_bf16(vf[1][0][0], pb00, o1, 0, 0, 0); o1 = __builtin_amdgcn_mfma_f32_32x32x16_bf16(vf[1][0][1], pb01, o1, 0, 0, 0);
        o1 = __builtin_amdgcn_mfma_f32_32x32x16_bf16(vf[1][1][0], pb10, o1, 0, 0, 0); o1 = __builtin_amdgcn_mfma_f32_32x32x16_bf16(vf[1][1][1], pb11, o1, 0, 0, 0);
        if (kt > 0) {
            if (FOX) { const float ub = qk + ct - c2[64 * kt]; if (__all(ub < m - 50.f)) break; }
            else { if (__all(carry < 7.8e-31f)) break; }
        }
    }
    float inv = 1.f;
    if (FOX) { const float lt = l + __shfl_xor(l, 32); inv = 1.f / lt; }
    float ss = 0.f;
#pragma unroll
    for (int r = 0; r < 16; ++r) { o0[r] *= inv; o1[r] *= inv; ss += o0[r] * o0[r] + o1[r] * o1[r]; }
    ss += __shfl_xor(ss, 32);
    const float rn = __builtin_amdgcn_rsqf(ss * (1.f / 64.f) + EPS);
    const int colb = (FOX ? 0 : 384) + h * 64 + 4 * hh;
    const float* on = F.in[IN_OUT_NORM] + layer * DM + colb;
    bf16* dst = (bf16*)(ws + WS_MIX) + (tok0 + qa) * DM + colb;
#pragma unroll
    for (int g = 0; g < 4; ++g) {
        const f32x4 g0 = *(const f32x4*)(on + 8 * g), g1 = *(const f32x4*)(on + 32 + 8 * g);
        u32x2 w0, w1;
        w0.x = pk2(o0[4 * g] * rn * g0[0], o0[4 * g + 1] * rn * g0[1]); w0.y = pk2(o0[4 * g + 2] * rn * g0[2], o0[4 * g + 3] * rn * g0[3]);
        w1.x = pk2(o1[4 * g] * rn * g1[0], o1[4 * g + 1] * rn * g1[1]); w1.y = pk2(o1[4 * g + 2] * rn * g1[2], o1[4 * g + 3] * rn * g1[3]);
        *(u32x2*)(dst + 8 * g) = w0; *(u32x2*)(dst + 32 + 8 * g) = w1;
    }
}

__device__ __forceinline__ void s5_chunk_state(const Frame& F, int layer, int b, int g, int k) {
    unsigned char* ws = F.ws;
    LAS float* us = (LAS float*)(F.lds + F.wave * 4096);
    const float* tb = (const float*)(ws + WS_S5T) + (size_t)(layer * NG + g) * 2304;
    const int n = F.lane;
    const float ar = tb[n], ai = tb[64 + n];
    f32x4 br[4], bi[4];
#pragma unroll
    for (int j = 0; j < 4; ++j) { br[j] = *(const f32x4*)(tb + 256 + n * 16 + 4 * j); bi[j] = *(const f32x4*)(tb + 1280 + n * 16 + 4 * j); }
    const float* up = (const float*)(ws + WS_SU) + ((size_t)b * SEQ + 64 * k + F.lane) * SSMW + 16 * g;
#pragma unroll
    for (int j = 0; j < 4; ++j) *(LAS f32x4*)(us + F.lane * 16 + 4 * j) = *(const f32x4*)(up + 4 * j);
    LDS_WAIT();
    float hr = 0.f, hi = 0.f;
    for (int t = 0; t < CH; ++t) {
        float sr = 0.f, si = 0.f;
#pragma unroll
        for (int j = 0; j < 4; ++j) { const f32x4 u = *(const LAS f32x4*)(us + t * 16 + 4 * j);
            sr += (br[j][0] * u[0] + br[j][1] * u[1]) + (br[j][2] * u[2] + br[j][3] * u[3]); si += (bi[j][0] * u[0] + bi[j][1] * u[1]) + (bi[j][2] * u[2] + bi[j][3] * u[3]); }
        const float nr = ar * hr - ai * hi + sr, ni = ar * hi + ai * hr + si; hr = nr; hi = ni;
    }
    ((f32x2*)(ws + WS_SEND))[((size_t)(b * NG + g) * NCH + k) * 64 + n] = (f32x2){hr, hi};
    LDS_WAIT();
}

__device__ __forceinline__ void attn_phase(const Frame& F, int layer) {
    const float kg = fabsf(F.in[IN_FKN][layer * 64 + F.lane]);
    const float kbound = wave_max(kg) * 8.f * 1.01f;
    gu32* head = F.ctl + CW_QHEAD + 64 * layer;
    constexpr int NATT = 24 * 256;
    for (;;) {
        unsigned t = 0u; if (F.lane == 0) t = __hip_atomic_fetch_add(head, 1u, RLX_AGENT);
        const int idx = __builtin_amdgcn_readfirstlane((int)t);
        if (idx >= 2 * NATT + NB * NG * NCH) break;
        if (idx < 2 * NATT) {
            const int j = (idx < NATT) ? idx : idx - NATT;
            const int bh = j >> 8, qb = 255 - (j & 255);
            if (idx < NATT) attn_item<true>(F, layer, bh / 6, bh % 6, qb, kbound);
            else attn_item<false>(F, layer, bh / 6, bh % 6, qb, kbound);
        } else {
            const int j = idx - 2 * NATT; s5_chunk_state(F, layer, j >> 11, (j >> 7) & 15, j & 127);
        }
    }
}

__device__ __forceinline__ float gelu_tanh(float x) { const float u = 0.7978845608028654f * (x + 0.044715f * x * x * x); return x * frcp(1.f + fexp2(-2.f * LOG2E * u)); }
constexpr int S5_WLDS = 12800, S5_HS = 132, S5_GOFF = 8 * S5_WLDS, S5_GP = 264;
__device__ __forceinline__ void s5_out_phase(const Frame& F, int layer) {
    unsigned char* ws = F.ws;
    LAS float* us = (LAS float*)(F.lds + F.wave * S5_WLDS);
    LAS float* hs = us + 1024;
    LAS bf16* G = (LAS bf16*)(F.lds + S5_GOFF);
    const int lane = F.lane, n = lane, c16 = lane & 15, kq = lane >> 4;
    for (int unit = F.vcu; unit < NB * NCH; unit += F.G) {
        const int b = unit / NCH, k = unit - b * NCH;
        for (int gi = 0; gi < 2; ++gi) {
            const int g = 2 * F.wave + gi;
            const float* tb = (const float*)(ws + WS_S5T) + (size_t)(layer * NG + g) * 2304;
            const float ar = tb[n], ai = tb[64 + n], lr = tb[128 + n], li = tb[192 + n];
            f32x4 br[4], bi[4];
#pragma unroll
            for (int j = 0; j < 4; ++j) { br[j] = *(const f32x4*)(tb + 256 + n * 16 + 4 * j); bi[j] = *(const f32x4*)(tb + 1280 + n * 16 + 4 * j); }
            float hr = 0.f, hi = 0.f;
            const f32x2* se = (const f32x2*)(ws + WS_SEND) + (size_t)(b * NG + g) * NCH * 64 + n;
            for (int kk = 0; kk < k; kk += 16) {
                f32x2 sv[16];
#pragma unroll
                for (int j = 0; j < 16; ++j) { const int ki = (kk + j < k) ? kk + j : k - 1; sv[j] = *(const GAS f32x2*)(se + (size_t)ki * 64); }
#pragma unroll
                for (int j = 0; j < 16; ++j) if (kk + j < k) { const float nr = lr * hr - li * hi + sv[j].x, ni = lr * hi + li * hr + sv[j].y; hr = nr; hi = ni; }
            }
            const float* cre = F.in[IN_C_RE] + ((size_t)(layer * NG + g) * SG + c16) * NS; const float* cim = F.in[IN_C_IM] + ((size_t)(layer * NG + g) * SG + c16) * NS;
            float cm[32];
#pragma unroll
            for (int ks = 0; ks < 16; ++ks) { cm[ks] = cre[4 * ks + kq]; cm[16 + ks] = -cim[4 * ks + kq]; }
            const float dsk = F.in[IN_SSM_D][layer * SSMW + 16 * g + c16];
            const float* up = (const float*)(ws + WS_SU) + ((size_t)b * SEQ + 64 * k + lane) * SSMW + 16 * g;
#pragma unroll
            for (int j = 0; j < 4; ++j) *(LAS f32x4*)(us + lane * 16 + 4 * j) = *(const f32x4*)(up + 4 * j);
            LDS_WAIT();
            for (int sc = 0; sc < 4; ++sc) {
                for (int t = 0; t < 16; ++t) {
                    float sr = 0.f, si = 0.f;
#pragma unroll
                    for (int j = 0; j < 4; ++j) { const f32x4 u = *(const LAS f32x4*)(us + (16 * sc + t) * 16 + 4 * j);
                        sr += (br[j][0] * u[0] + br[j][1] * u[1]) + (br[j][2] * u[2] + br[j][3] * u[3]); si += (bi[j][0] * u[0] + bi[j][1] * u[1]) + (bi[j][2] * u[2] + bi[j][3] * u[3]); }
                    const float nr = ar * hr - ai * hi + sr, ni = ar * hi + ai * hr + si; hr = nr; hi = ni;
                    hs[t * S5_HS + n] = hr; hs[t * S5_HS + 64 + n] = hi;
                }
                LDS_WAIT();
                f32x4 y = {0.f, 0.f, 0.f, 0.f};
#pragma unroll
                for (int ks = 0; ks < 32; ++ks) { const float a = hs[c16 * S5_HS + 4 * ks + kq]; y = __builtin_amdgcn_mfma_f32_16x16x4f32(a, cm[ks], y, 0, 0, 0); }
#pragma unroll
                for (int i = 0; i < 4; ++i) { const int tl = 16 * sc + 4 * kq + i; const float yy = y[i] + dsk * us[tl * 16 + c16]; G[tl * S5_GP + 16 * g + c16] = (bf16)f2bf(gelu_tanh(yy)); }
                LDS_WAIT();
            }
        }
        __syncthreads();
        {
            const bf16* Wt = (const bf16*)(ws + WS_WGLU) + (size_t)layer * 65536;
            f32x4 z[4][2];
#pragma unroll
            for (int rb = 0; rb < 4; ++rb)
#pragma unroll
                for (int cb = 0; cb < 2; ++cb) z[rb][cb] = (f32x4){0.f, 0.f, 0.f, 0.f};
#pragma unroll
            for (int ks = 0; ks < 8; ++ks) {
                bf16x8 bfr[2], afr[4];
#pragma unroll
                for (int cb = 0; cb < 2; ++cb) bfr[cb] = *(const bf16x8*)(Wt + (size_t)(32 * F.wave + 16 * cb + c16) * 256 + 32 * ks + 8 * kq);
#pragma unroll
                for (int rb = 0; rb < 4; ++rb) afr[rb] = *(const LAS bf16x8*)(G + (16 * rb + c16) * S5_GP + 32 * ks + 8 * kq);
#pragma unroll
                for (int rb = 0; rb < 4; ++rb)
#pragma unroll
                    for (int cb = 0; cb < 2; ++cb) z[rb][cb] = __builtin_amdgcn_mfma_f32_16x16x32_bf16(afr[rb], bfr[cb], z[rb][cb], 0, 0, 0);
            }
#pragma unroll
            for (int cb = 0; cb < 2; ++cb) {
                const int oc = 32 * F.wave + 16 * cb + c16;
                const float bg = F.in[IN_B_GLU][layer * SSMW + oc], on = F.in[IN_OUT_NORM][layer * DM + 768 + oc];
#pragma unroll
                for (int rb = 0; rb < 4; ++rb)
#pragma unroll
                    for (int i = 0; i < 4; ++i) {
                        const int tl = 16 * rb + 4 * kq + i;
                        const float gg = bf2f(G[tl * S5_GP + oc]);
                        const float v = gg * frcp(1.f + fexp2(-(z[rb][cb][i] + bg) * LOG2E));
                        float ss = v * v; ss += __shfl_xor(ss, 1); ss += __shfl_xor(ss, 2); ss += __shfl_xor(ss, 4); ss += __shfl_xor(ss, 8);
                        const float o = v * __builtin_amdgcn_rsqf(ss * (1.f / 16.f) + EPS) * on;
                        ((bf16*)(ws + WS_MIX))[((size_t)b * SEQ + 64 * k + tl) * DM + 768 + oc] = (bf16)f2bf(o);
                    }
            }
        }
        __syncthreads();
    }
}

#ifndef PHM
#define PHM 0xffff
#endif
__device__ __forceinline__ Frame make_frame(unsigned char* ws_in, LAS unsigned char* lds) {
    Frame F; unsigned char* ws = ws_in; asm volatile("" : "+s"(ws));
    int tid = threadIdx.x; asm volatile("" : "+v"(tid));
    F.lds = lds; F.tid = tid; F.lane = tid & 63; F.wave = __builtin_amdgcn_readfirstlane(tid >> 6);
    F.G = gridDim.x; { const int bx = blockIdx.x; F.vcu = (bx % 8) * (F.G / 8) + bx / 8; }
    F.ws = ws; F.ctl = (gu32*)(ws + WS_CTL); F.in = (const float* const*)(ws + WS_PTRS); F.out = nullptr;
    return F;
}
__global__ void __launch_bounds__(512, 2) hybrid_fwd(Args args) {
    extern __shared__ __attribute__((aligned(16))) unsigned char lds_raw[];
    LAS unsigned char* const lds = (LAS unsigned char*)lds_raw;
    for (int u = threadIdx.x; u < (LDS_BYTES - LDS_CTL) / 4; u += 512) ((LAS unsigned*)(lds + LDS_CTL))[u] = 0u;
    __syncthreads();
    XcdBarrier bar = xcd_barrier_post((unsigned*)(args.ws + WS_CTL) + CW_BAR + args.li * XCD_BAR_WORDS, (volatile LAS unsigned*)(lds + LDS_CTL) + 8);
    const int lo = args.ph_lo, hi = args.ph_hi;
    int ph = 0;
#define PH_BEGIN if (ph >= lo && ph < hi) { Frame F = make_frame(args.ws, lds); unsigned char* const ws = F.ws; (void)ws; int layer = layer_; asm volatile("" : "+s"(layer)); const bool moe = (layer & 1) != 0; const int j2 = layer >> 1; (void)moe; (void)j2;
#define PH_END   if (ph + 1 < hi) xcd_barrier(bar); } ++ph;
    const size_t TS1 = (size_t)256 * DM * 2, TS3 = (size_t)256 * DFF * 2;

    { const int layer_ = 0; PH_BEGIN F.out = args.out; if (PHM & 1) p0_prologue(F, args); PH_END }

    for (int layer_ = 0; layer_ < NL; ++layer_) {
        PH_BEGIN F.out = (float*)F.in[26]; if (PHM & 2) norm_phase<0>(F, layer, layer > 0 && ((layer - 1) & 1), (layer == 0) ? F.in[IN_X] : F.out); PH_END
        PH_BEGIN
            if (PHM & 4) cumsum_phase(F);
            __syncthreads();
            { const pg8::SchedLds S = pg8::build_units_plain(F.lds, F.tid, F.G, (int)blockIdx.x, T / 256, NQK / 256, (const char*)(ws + WS_XN), (const char*)(ws + WS_WIN) + (size_t)layer * 2560 * DM * 2, TS1);
              pg8::EpiProj E{(bf16*)(ws + WS_FQ), (bf16*)(ws + WS_FK), (bf16*)(ws + WS_SQ), (bf16*)(ws + WS_SK), (float*)(ws + WS_SU), F.in[IN_FQN] + layer * 64, F.in[IN_FKN] + layer * 64};
              if (PHM & 8) pg8::gemm_phase<pg8::EpiProj, pg8::SchedLds, true, true>(F.lds, F.tid, DM, S, E); }
            { const pg8::SchedLds S = pg8::build_units_plain(F.lds, F.tid, F.G, (int)blockIdx.x, NVT / 256, T / 256, (const char*)(ws + WS_WIN) + ((size_t)layer * 2560 + NQK) * DM * 2, (const char*)(ws + WS_XN), TS1);
              pg8::EpiStoreBf16 E{(bf16*)(ws + WS_VT), T, 0};
              if (PHM & 16) pg8::gemm_phase<pg8::EpiStoreBf16, pg8::SchedLds, true, true>(F.lds, F.tid, DM, S, E); }
        PH_END
        PH_BEGIN if (PHM & 32) attn_phase(F, layer); PH_END
        PH_BEGIN if (PHM & 64) s5_out_phase(F, layer); PH_END
        PH_BEGIN
            { float* const outp = (float*)F.in[26];
              const pg8::SchedLds S = pg8::build_units_plain(F.lds, F.tid, F.G, (int)blockIdx.x, T / 256, DM / 256, (const char*)(ws + WS_MIX), (const char*)(ws + WS_WOUT) + (size_t)layer * DM * DM * 2, TS1);
              pg8::EpiResid E{(layer == 0) ? F.in[IN_X] : (const float*)outp, outp};
              if (PHM & 128) pg8::gemm_phase<pg8::EpiResid, pg8::SchedLds, true, true>(F.lds, F.tid, DM, S, E); }
        PH_END
        if (!(layer_ & 1)) {
            PH_BEGIN F.out = (float*)F.in[26]; if (PHM & 256) norm_phase<1>(F, layer, false, F.out); PH_END
            PH_BEGIN
                { const pg8::SchedLds S = pg8::build_units_plain(F.lds, F.tid, F.G, (int)blockIdx.x, T / 256, 28, (const char*)(ws + WS_XN), (const char*)(ws + WS_DGU) + (size_t)j2 * 7168 * DM * 2, TS1);
                  pg8::EpiSwiglu E{(bf16*)(ws + WS_HID), 0};
                  if (PHM & 512) pg8::gemm_phase<pg8::EpiSwiglu, pg8::SchedLds, true, true>(F.lds, F.tid, DM, S, E); }
            PH_END
            PH_BEGIN
                { float* const outp = (float*)F.in[26];
                  const pg8::SchedLds S = pg8::build_units_plain(F.lds, F.tid, F.G, (int)blockIdx.x, T / 256, DM / 256, (const char*)(ws + WS_HID), (const char*)(ws + WS_DDN) + (size_t)j2 * DM * DFF * 2, TS3);
                  pg8::EpiResid E{outp, outp};
                  if (PHM & 1024) pg8::gemm_phase<pg8::EpiResid, pg8::SchedLds, true, true>(F.lds, F.tid, DFF, S, E); }
            PH_END
        } else {
            PH_BEGIN F.out = (float*)F.in[26]; if (PHM & 2048) norm_phase<2>(F, layer, false, F.out); PH_END
            PH_BEGIN if (PHM & 4096) moe_gather_phase(F); PH_END
            for (int pass_ = 0; pass_ < 2; ++pass_) {
                PH_BEGIN int pass = pass_; asm volatile("" : "+s"(pass));
                    { const int* mb = (const int*)(ws + WS_MOEB); const int ntl = mb[8]; const int tlo = pass * MOE_PASS_TILES; int nM = ntl - tlo; nM = nM < 0 ? 0 : (nM > MOE_PASS_TILES ? MOE_PASS_TILES : nM);
                      const pg8::SchedLds S = pg8::build_units_moe(F.lds, F.tid, F.G, (int)blockIdx.x, nM, 28, tlo, mb, (const char*)(ws + WS_R2), (const char*)(ws + WS_MGU) + (size_t)j2 * 8 * 7168 * DM * 2, TS1, TS1, (size_t)7168 * DM * 2, false);
                      pg8::EpiSwiglu E{(bf16*)(ws + WS_HID), tlo};
                      if (PHM & 8192) pg8::gemm_phase<pg8::EpiSwiglu, pg8::SchedLds, true, true>(F.lds, F.tid, DM, S, E); }
                PH_END
                PH_BEGIN int pass = pass_; asm volatile("" : "+s"(pass));
                    { const int* mb = (const int*)(ws + WS_MOEB); const int ntl = mb[8]; const int tlo = pass * MOE_PASS_TILES; int nM = ntl - tlo; nM = nM < 0 ? 0 : (nM > MOE_PASS_TILES ? MOE_PASS_TILES : nM);
                      const pg8::SchedLds S = pg8::build_units_moe(F.lds, F.tid, F.G, (int)blockIdx.x, nM, DM / 256, tlo, mb, (const char*)(ws + WS_HID), (const char*)(ws + WS_MDN) + (size_t)j2 * 8 * DM * DFF * 2, TS3, TS3, (size_t)DM * DFF * 2, true);
                      pg8::EpiStoreBf16 E{(bf16*)(ws + WS_R2), DM, 0};
                      if (PHM & 16384) pg8::gemm_phase<pg8::EpiStoreBf16, pg8::SchedLds, true, true>(F.lds, F.tid, DFF, S, E); }
                PH_END
            }
        }
    }
    { const int layer_ = NL; PH_BEGIN F.out = (float*)F.in[26]; if (PHM & 32768) norm_phase<3>(F, NL, true, F.out); PH_END }
#undef PH_BEGIN
#undef PH_END
}

#ifndef MK_SPLIT
#define MK_SPLIT 0
#endif
extern "C" void kernel_launch(void* const* d_in, const int* in_sizes, int n_in, void* d_out, int out_size, void* d_ws, size_t ws_size, hipStream_t stream) {
    static int grid = 0;
    if (grid == 0) {
        if (n_in != 26 || in_sizes[0] != T * DM || out_size != T * DM || ws_size < WS_END) {
            fprintf(stderr, "kernel_launch: unexpected problem (n_in %d, in0 %d, out %d, ws %zu < %zu); nothing launched\n", n_in, n_in > 0 ? in_sizes[0] : -1, out_size, ws_size, (size_t)WS_END); grid = -1; return; }
        int dev = 0, cus = 0, per_cu = 0;
        if (hipGetDevice(&dev) != hipSuccess || hipDeviceGetAttribute(&cus, hipDeviceAttributeMultiprocessorCount, dev) != hipSuccess) { grid = -1; return; }
        if (hipFuncSetAttribute((const void*)hybrid_fwd, hipFuncAttributeMaxDynamicSharedMemorySize, LDS_BYTES) != hipSuccess) { fprintf(stderr, "kernel_launch: hipFuncSetAttribute failed\n"); grid = -1; return; }
        if (hipOccupancyMaxActiveBlocksPerMultiprocessor(&per_cu, (const void*)hybrid_fwd, 512, LDS_BYTES) != hipSuccess || per_cu < 1) { fprintf(stderr, "kernel_launch: occupancy query says %d\n", per_cu); }
        (void)hipGetLastError();
        if (cus != 256) { fprintf(stderr, "kernel_launch: built for 256 CUs, device has %d; nothing launched\n", cus); grid = -1; return; }
        grid = 256;
    }
    if (grid < 0) return;
    if (hipMemsetAsync((char*)d_ws + WS_CTL, 0, CTL_BYTES, stream) != hipSuccess) return;
    Args a{};
    for (int i = 0; i < 26; ++i) a.in[i] = (const float*)d_in[i];
    a.out = (float*)d_out; a.ws = (unsigned char*)d_ws; a.pad = 0;
    constexpr int NPHASE = 64;
    if (MK_SPLIT == 0) { a.ph_lo = 0; a.ph_hi = NPHASE; a.li = 0; hipLaunchKernelGGL(hybrid_fwd, dim3(grid), dim3(512), LDS_BYTES, stream, a); }
    else { int li = 0; for (int p = 0; p < 48; p += MK_SPLIT, ++li) { a.ph_lo = p; a.ph_hi = p + MK_SPLIT; a.li = li; hipLaunchKernelGGL(hybrid_fwd, dim3(grid), dim3(512), LDS_BYTES, stream, a); } }
}
```

```cpp
#include <hip/hip_runtime.h>
#include <cstdio>
#include <cstdint>
#include <cmath>

#define GAS __attribute__((address_space(1)))
#define LAS __attribute__((address_space(3)))
typedef unsigned short bf16;
typedef short bf16x8 __attribute__((ext_vector_type(8)));
typedef float f32x4 __attribute__((ext_vector_type(4)));
typedef float f32x2 __attribute__((ext_vector_type(2)));
typedef float f32x16 __attribute__((ext_vector_type(16)));
typedef unsigned u32x4 __attribute__((ext_vector_type(4)));
typedef unsigned u32x2 __attribute__((ext_vector_type(2)));
typedef GAS unsigned gu32;

constexpr int NB = 4, SEQ = 8192, DM = 1024, NL = 4;
constexpr int T = NB * SEQ;
constexpr int HD = 64, NHF = 6, NHS = 6;
constexpr int PROJW = 2566;
constexpr int NQK = 1792;
constexpr int NVT = 768;
constexpr int SSMW = 256, SG = 16, NG = 16, NS = 64;
constexpr int DFF = 3584, NE = 8;
constexpr int CH = 64, NCH = SEQ / CH;
constexpr float EPS = 1e-6f;
constexpr float LOG2E = 1.4426950408889634f;
constexpr float QSCALE = 0.125f * LOG2E;
constexpr int MOE_TILES_MAX = 264, MOE_PASS_TILES = 132;

constexpr size_t MiB = 1u << 20;
constexpr size_t WS_CTL = 0, CTL_BYTES = 1 * MiB;
constexpr size_t WS_S5T = 1 * MiB;
constexpr size_t WS_WGLU = 2 * MiB;
constexpr size_t WS_LOGF = 3 * MiB;
constexpr size_t WS_C2 = 4 * MiB;
constexpr size_t WS_SEND = 5 * MiB;
constexpr size_t WS_RTE = 9 * MiB;
constexpr size_t WS_RTW = WS_RTE + 256 * 1024;
constexpr size_t WS_LRANK = WS_RTW + 256 * 1024;
constexpr size_t WS_TOKROW = WS_LRANK + 256 * 1024;
constexpr size_t WS_WGCNT = 10 * MiB;
constexpr size_t WS_MOEB = WS_WGCNT + 16384;
constexpr size_t WS_PTRS = WS_WGCNT + 32768;
constexpr size_t WS_WIN = 12 * MiB;
constexpr size_t WS_WOUT = 32 * MiB;
constexpr size_t WS_DGU = 40 * MiB;
constexpr size_t WS_DDN = 68 * MiB;
constexpr size_t WS_MGU = 82 * MiB;
constexpr size_t WS_MDN = 306 * MiB;
constexpr size_t WS_XN = 418 * MiB;
constexpr size_t WS_R1 = 482 * MiB;
constexpr size_t WS_FQ = WS_R1, WS_FK = WS_R1 + 24 * MiB, WS_SQ = WS_R1 + 48 * MiB, WS_SK = WS_R1 + 72 * MiB;
constexpr size_t WS_VT = WS_R1 + 96 * MiB;
constexpr size_t WS_SU = WS_R1 + 144 * MiB;
constexpr size_t WS_MIX = WS_R1 + 176 * MiB;
constexpr size_t WS_HID = WS_R1;
constexpr size_t WS_R2 = 722 * MiB;
constexpr size_t WS_END = 854 * MiB;
constexpr int CW_TMO = 0;
constexpr int CW_QHEAD = 64;
constexpr int CW_BAR = 4096;

constexpr int LDS_BYTES = 155648;
constexpr int LDS_CTL = 154624;
constexpr int RING_BYTES = 131072;

#define RLX_AGENT __ATOMIC_RELAXED, __HIP_MEMORY_SCOPE_AGENT
#define LDS_WAIT() asm volatile("s_waitcnt lgkmcnt(0)" ::: "memory")
__device__ __forceinline__ unsigned f2bf(float f) { unsigned u = __builtin_bit_cast(unsigned, f); return (u + 0x7fffu + ((u >> 16) & 1u)) >> 16; }
__device__ __forceinline__ unsigned pk2(float lo, float hi) { typedef __bf16 bf2 __attribute__((ext_vector_type(2))); f32x2 v = {lo, hi}; bf2 b = __builtin_convertvector(v, bf2); return __builtin_bit_cast(unsigned, b); }
__device__ __forceinline__ float bf2f(unsigned short h) { return __builtin_bit_cast(float, (unsigned)h << 16); }
__device__ __forceinline__ float wave_sum(float v) {
#pragma unroll
    for (int o = 1; o < 64; o <<= 1) v += __shfl_xor(v, o);
    return v;
}
__device__ __forceinline__ float wave_max(float v) {
#pragma unroll
    for (int o = 1; o < 64; o <<= 1) v = fmaxf(v, __shfl_xor(v, o));
    return v;
}
__device__ __forceinline__ float fexp2(float x) { return __builtin_amdgcn_exp2f(x); }
__device__ __forceinline__ float frcp(float x) { return __builtin_amdgcn_rcpf(x); }

namespace pg8 {
constexpr int BM = 256, BK = 64, HALF = 128, HTB = HALF * BK * 2, STAGE_BYTES = 8 * HTB, NXCD = 8, WGM = 8;
__host__ __device__ __forceinline__ int lds_byte(int r, int c) { const int st = (r >> 4) * 2 + (c >> 5), rr = r & 15, cc = c & 31, ob = rr * 64 + cc * 2; return st * 1024 + (ob ^ (((ob >> 9) & 1) << 5)); }
__host__ __device__ __forceinline__ void stage_rc(int b, int& R, int& C) { const int st = b / 1024, sb = b % 1024, swz = sb ^ (((sb >> 9) & 1) << 5); R = (st >> 1) * 16 + swz / 64; C = (st & 1) * 32 + (swz % 64) / 2; }
__host__ __device__ __forceinline__ int perm32(int rho) { const int n = rho >> 4, i = rho & 15; return 8 * (i >> 2) + 4 * n + (i & 3); }

struct Unit { int pm, pn, e; const char* A; const char* B; };

__device__ __forceinline__ bool tile_order(int i, int G, int c, int nM, int nN, int& pm, int& pn) {
    const int nwg = nM * nN; const long L = (long)i * G + c; if (L >= nwg) return false;
    int wgid = (int)L; { const int q = nwg / NXCD, r = nwg % NXCD, xcd = wgid % NXCD, off = wgid / NXCD; wgid = (xcd < r ? xcd * (q + 1) : r * (q + 1) + (xcd - r) * q) + off; }
    const int nig = WGM * nN, gid = wgid / nig, fm = gid * WGM, gsz = (nM - fm) < WGM ? (nM - fm) : WGM;
    pm = fm + ((wgid % nig) % gsz); pn = (wgid % nig) / gsz; return true;
}
constexpr int UNITS_OFF = 131072, UNITS_MAX = 64;
struct SchedLds {
    const LAS unsigned* list; int cnt;
    __device__ __forceinline__ bool next(int i, Unit& u) const {
        if (i >= cnt) return false;
        const u32x4 a = *(const LAS u32x4*)(list + 8 * i), b = *(const LAS u32x4*)(list + 8 * i + 4);
        u.pm = __builtin_amdgcn_readfirstlane((int)a.x); u.pn = __builtin_amdgcn_readfirstlane((int)a.y); u.e = __builtin_amdgcn_readfirstlane((int)a.z);
        const unsigned alo = __builtin_amdgcn_readfirstlane(b.x), ahi = __builtin_amdgcn_readfirstlane(b.y), blo = __builtin_amdgcn_readfirstlane(b.z), bhi = __builtin_amdgcn_readfirstlane(b.w);
        u.A = (const char*)(((unsigned long long)ahi << 32) | alo); u.B = (const char*)(((unsigned long long)bhi << 32) | blo); return true;
    }
};
__device__ __forceinline__ void put_unit(LAS unsigned* list, int i, int pm, int pn, int e, const char* A, const char* B) {
    const unsigned long long a = (unsigned long long)A, b = (unsigned long long)B;
    *(LAS u32x4*)(list + 8 * i) = (u32x4){(unsigned)pm, (unsigned)pn, (unsigned)e, 0u}; *(LAS u32x4*)(list + 8 * i + 4) = (u32x4){(unsigned)a, (unsigned)(a >> 32), (unsigned)b, (unsigned)(b >> 32)};
}
__device__ __forceinline__ SchedLds build_units_plain(LAS unsigned char* lds, int tid, int G, int c, int nM, int nN, const char* A0, const char* B0, size_t tstep) {
    LAS unsigned* list = (LAS unsigned*)(lds + UNITS_OFF);
    int pm, pn; int cnt = 0;
    if (tid < UNITS_MAX && tile_order(tid, G, c, nM, nN, pm, pn)) put_unit(list, tid, pm, pn, 0, A0 + (size_t)pm * tstep, B0 + (size_t)pn * tstep);
    { const int nwg = nM * nN; cnt = (c < nwg) ? (nwg - c + G - 1) / G : 0; }
    LDS_WAIT(); __syncthreads();
    return SchedLds{list, cnt};
}
__device__ __forceinline__ SchedLds build_units_moe(LAS unsigned char* lds, int tid, int G, int c, int nM, int nN, int tlo, const int* eb, const char* A0, const char* B0, size_t tstepA, size_t tstepB, size_t estride, bool a_local) {
    LAS unsigned* list = (LAS unsigned*)(lds + UNITS_OFF);
    int pm, pn; int cnt = 0;
    if (tid < UNITS_MAX && tile_order(tid, G, c, nM, nN, pm, pn)) {
        const int gp = tlo + pm; int e = 0;
        for (int j = 1; j < 8; ++j) e += (gp >= eb[j]) ? 1 : 0;
        put_unit(list, tid, gp, pn, e, A0 + (size_t)(a_local ? pm : gp) * tstepA, B0 + (size_t)e * estride + (size_t)pn * tstepB);
    }
    { const int nwg = nM * nN; cnt = (c < nwg) ? (nwg - c + G - 1) / G : 0; }
    LDS_WAIT(); __syncthreads();
    return SchedLds{list, cnt};
}

template <class Epi, class Sched, bool ALIGN_EPI, bool SP2>
__device__ __forceinline__ void gemm_phase(LAS unsigned char* lds, const int tid, const int K, const Sched& S, const Epi& E) {
    const int wid = __builtin_amdgcn_readfirstlane(tid >> 6), lane = tid & 63, wr = wid >> 2, wc = wid & 3, fr = lane & 15, fq = lane >> 4;
    const int nt = K / BK;
    unsigned voffA[2], voffB[2];
#pragma unroll
    for (int i = 0; i < 2; ++i) { int R, C; stage_rc(tid * 16 + i * 8192, R, C); const int Rb = Epi::PERM ? ((R & ~31) + perm32(R & 31)) : R;
        voffA[i] = (unsigned)(R * K + C) * 2u; voffB[i] = (unsigned)(Rb * K + C) * 2u; }
    const size_t kstep = (size_t)(BK * 2);
    const size_t hstep = (size_t)HALF * K * 2;
    const unsigned ldsw = (unsigned)wid * 1024u;
    const int aoff = lds_byte(wr * 64 + fr, fq * 8), boff = lds_byte(wc * 32 + fr, fq * 8);
#define PG8_SA(b, h) (((b) * 2 + (h)) * HTB)
#define PG8_SB(b, h) ((4 + (b) * 2 + (h)) * HTB)
#define PG8_STAGE(bufoff, gbase, voff) do { _Pragma("unroll") for (int _i = 0; _i < 2; ++_i) \
        __builtin_amdgcn_global_load_lds((const unsigned*)((const char*)(gbase) + (voff)[_i]), (LAS unsigned*)(lds + (bufoff) + ldsw + _i * 8192), 16, 0, 0); } while (0)
#define PG8_LDA(dst, b, h) do { _Pragma("unroll") for (int m = 0; m < 4; ++m) _Pragma("unroll") for (int k = 0; k < 2; ++k) dst[m][k] = *(const LAS bf16x8*)(lds + PG8_SA(b, h) + aoff + m * 2048 + k * 1024); } while (0)
#define PG8_LDB(dst, b, h) do { _Pragma("unroll") for (int n = 0; n < 2; ++n) _Pragma("unroll") for (int k = 0; k < 2; ++k) dst[n][k] = *(const LAS bf16x8*)(lds + PG8_SB(b, h) + boff + n * 2048 + k * 1024); } while (0)
#define PG8_MMA(ai, bj, At, Bt) do { __builtin_amdgcn_s_setprio(1); _Pragma("unroll") for (int m = 0; m < 4; ++m) _Pragma("unroll") for (int n = 0; n < 2; ++n) _Pragma("unroll") for (int k = 0; k < 2; ++k) \
        acc[ai][bj][m][n] = __builtin_amdgcn_mfma_f32_16x16x32_bf16(Bt[n][k], At[m][k], acc[ai][bj][m][n], 0, 0, 0); __builtin_amdgcn_s_setprio(0); } while (0)
#define PG8_WAIT_V(n) asm volatile("s_waitcnt vmcnt(" #n ")" ::: "memory")
#define PG8_WAIT_L(n) asm volatile("s_waitcnt lgkmcnt(" #n ")" ::: "memory")
#define PG8_BAR __builtin_amdgcn_s_barrier()
#define PG8_SCHED __builtin_amdgcn_sched_barrier(0)
    Unit cur, nxt; int ui = 0;
    if (!S.next(0, cur)) return;
    f32x4 acc[2][2][4][2];
#pragma unroll
    for (int a = 0; a < 2; ++a)
#pragma unroll
        for (int b = 0; b < 2; ++b)
#pragma unroll
            for (int m = 0; m < 4; ++m)
#pragma unroll
                for (int n = 0; n < 2; ++n) acc[a][b][m][n] = (f32x4){0.f, 0.f, 0.f, 0.f};
    bf16x8 At[4][2], B0[2][2], B1[2][2];
    const char* cA = cur.A; const char* cB = cur.B;
    if constexpr (SP2) {
        PG8_STAGE(PG8_SB(0, 0), cB, voffB); PG8_STAGE(PG8_SB(0, 1), cB + hstep, voffB); PG8_STAGE(PG8_SA(0, 0), cA, voffA); PG8_STAGE(PG8_SA(0, 1), cA + hstep, voffA);
        if (wr == 1) PG8_BAR;
        PG8_WAIT_V(2); PG8_BAR;
        PG8_STAGE(PG8_SB(1, 0), cB + kstep, voffB); PG8_STAGE(PG8_SA(1, 0), cA + kstep, voffA); PG8_STAGE(PG8_SB(1, 1), cB + hstep + kstep, voffB);
        PG8_WAIT_V(6); PG8_BAR;
    } else {
        PG8_STAGE(PG8_SB(0, 0), cB, voffB); PG8_STAGE(PG8_SA(0, 0), cA, voffA); PG8_STAGE(PG8_SB(0, 1), cB + hstep, voffB); PG8_STAGE(PG8_SA(0, 1), cA + hstep, voffA);
        if (wr == 1) PG8_BAR;
        PG8_WAIT_V(4); PG8_BAR;
        PG8_STAGE(PG8_SB(1, 0), cB + kstep, voffB); PG8_STAGE(PG8_SA(1, 0), cA + kstep, voffA); PG8_STAGE(PG8_SB(1, 1), cB + hstep + kstep, voffB);
        PG8_WAIT_V(6); PG8_BAR;
    }
    for (;;) {
        const bool has_next = S.next(ui + 1, nxt);
        const char* nA = has_next ? nxt.A : cA; const char* nB = has_next ? nxt.B : cB;
        for (int t = 0; t < nt; t += 2) {
            const bool last = (t == nt - 2);
            const char* a1 = cA + (size_t)(t + 1) * kstep;
            const char* a2 = last ? nA : cA + (size_t)(t + 2) * kstep; const char* b2 = last ? nB : cB + (size_t)(t + 2) * kstep;
            const char* a3 = a2 + kstep; const char* b3 = b2 + kstep;
            if constexpr (SP2) {
            PG8_LDB(B0, 0, 0); PG8_LDB(B1, 0, 1); PG8_SCHED; PG8_LDA(At, 0, 0); PG8_STAGE(PG8_SA(1, 1), a1 + hstep, voffA);
            PG8_WAIT_V(8); PG8_WAIT_L(0); PG8_BAR; PG8_MMA(0, 0, At, B0); PG8_MMA(0, 1, At, B1); PG8_BAR; PG8_SCHED;
            PG8_LDA(At, 0, 1); PG8_STAGE(PG8_SB(0, 0), b2, voffB); PG8_STAGE(PG8_SB(0, 1), b2 + hstep, voffB); PG8_STAGE(PG8_SA(0, 0), a2, voffA);
            PG8_WAIT_V(8); PG8_WAIT_L(0); PG8_BAR; PG8_MMA(1, 0, At, B0); PG8_MMA(1, 1, At, B1); PG8_BAR; PG8_SCHED;
            PG8_LDB(B0, 1, 0); PG8_LDB(B1, 1, 1); PG8_SCHED; PG8_LDA(At, 1, 0); PG8_STAGE(PG8_SA(0, 1), a2 + hstep, voffA);
            PG8_WAIT_V(8); PG8_WAIT_L(0); PG8_BAR; PG8_MMA(0, 0, At, B0); PG8_MMA(0, 1, At, B1); PG8_BAR; PG8_SCHED;
            PG8_LDA(At, 1, 1); PG8_STAGE(PG8_SB(1, 0), b3, voffB); PG8_STAGE(PG8_SB(1, 1), b3 + hstep, voffB); PG8_STAGE(PG8_SA(1, 0), a3, voffA);
            PG8_WAIT_V(8); PG8_WAIT_L(0); PG8_BAR; PG8_MMA(1, 0, At, B0); PG8_MMA(1, 1, At, B1); PG8_BAR; PG8_SCHED;
            } else {
            PG8_LDB(B0, 0, 0); PG8_SCHED; PG8_LDA(At, 0, 0); PG8_STAGE(PG8_SA(1, 1), a1 + hstep, voffA);
            PG8_WAIT_L(8); PG8_BAR; PG8_WAIT_L(0); PG8_MMA(0, 0, At, B0); PG8_BAR; PG8_SCHED;
            PG8_LDB(B1, 0, 1); PG8_STAGE(PG8_SB(0, 0), b2, voffB);
            PG8_BAR; PG8_WAIT_L(0); PG8_MMA(0, 1, At, B1); PG8_BAR;
            PG8_LDA(At, 0, 1); PG8_STAGE(PG8_SA(0, 0), a2, voffA);
            PG8_BAR; PG8_WAIT_L(0); PG8_MMA(1, 0, At, B0); PG8_BAR; PG8_SCHED;
            PG8_STAGE(PG8_SB(0, 1), b2 + hstep, voffB);
            PG8_WAIT_V(6); PG8_BAR; PG8_MMA(1, 1, At, B1); PG8_BAR;
            PG8_LDB(B0, 1, 0); PG8_SCHED; PG8_LDA(At, 1, 0); PG8_STAGE(PG8_SA(0, 1), a2 + hstep, voffA);
            PG8_WAIT_L(8); PG8_BAR; PG8_WAIT_L(0); PG8_MMA(0, 0, At, B0); PG8_BAR; PG8_SCHED;
            PG8_LDB(B1, 1, 1); PG8_STAGE(PG8_SB(1, 0), b3, voffB);
            PG8_BAR; PG8_WAIT_L(0); PG8_MMA(0, 1, At, B1); PG8_BAR;
            PG8_LDA(At, 1, 1); PG8_STAGE(PG8_SA(1, 0), a3, voffA);
            PG8_BAR; PG8_WAIT_L(0); PG8_MMA(1, 0, At, B0); PG8_BAR; PG8_SCHED;
            PG8_STAGE(PG8_SB(1, 1), b3 + hstep, voffB);
            PG8_WAIT_V(6); PG8_BAR; PG8_MMA(1, 1, At, B1); PG8_BAR;
            }
        }
        if constexpr (ALIGN_EPI) { if (wr == 0) PG8_BAR; }
        E(acc, cur, wr, wc, fr, fq);
        if (!has_next) break;
#pragma unroll
        for (int a = 0; a < 2; ++a)
#pragma unroll
            for (int b = 0; b < 2; ++b)
#pragma unroll
                for (int m = 0; m < 4; ++m)
#pragma unroll
                    for (int n = 0; n < 2; ++n) acc[a][b][m][n] = (f32x4){0.f, 0.f, 0.f, 0.f};
        cur = nxt; cA = nA; cB = nB; ++ui;
        if constexpr (ALIGN_EPI) { if (wr == 1) PG8_BAR; }
    }
    PG8_WAIT_V(0);
    if constexpr (!ALIGN_EPI) { if (wr == 0) PG8_BAR; }
    PG8_BAR;
#undef PG8_SA
#undef PG8_SB
#undef PG8_STAGE
#undef PG8_LDA
#undef PG8_LDB
#undef PG8_MMA
#undef PG8_WAIT_V
#undef PG8_WAIT_L
#undef PG8_BAR
#undef PG8_SCHED
}

typedef f32x4 Acc[2][2][4][2];

struct EpiProj {
    static constexpr bool PERM = true;
    bf16 *FQ, *FK, *SQ, *SK; float* SU; const float* qg; const float* kg;
    __device__ __forceinline__ void operator()(const Acc& acc, const Unit& u, int wr, int wc, int fr, int fq) const {
        const int g = 4 * u.pn + wc; const int row0 = u.pm * BM + wr * 64 + fr;
        if (g < 12) {
            const float* gp = (g < 6 ? qg : kg); const float sc = (g < 6) ? QSCALE : 1.f;
            bf16* dst = (g < 6 ? FQ + g * 64 : FK + (g - 6) * 64);
            f32x4 gv[2][2];
#pragma unroll
            for (int bj = 0; bj < 2; ++bj)
#pragma unroll
                for (int n = 0; n < 2; ++n) gv[bj][n] = *(const f32x4*)(gp + 32 * bj + 8 * fq + 4 * n) * sc;
#pragma unroll
            for (int ai = 0; ai < 2; ++ai)
#pragma unroll
                for (int m = 0; m < 4; ++m) {
                    float ss = 0.f;
#pragma unroll
                    for (int bj = 0; bj < 2; ++bj)
#pragma unroll
                        for (int n = 0; n < 2; ++n) { const f32x4 v = acc[ai][bj][m][n]; ss += (v[0] * v[0] + v[1] * v[1]) + (v[2] * v[2] + v[3] * v[3]); }
                    ss += __shfl_xor(ss, 16); ss += __shfl_xor(ss, 32);
                    const float r = __builtin_amdgcn_rsqf(ss * (1.f / 64.f) + EPS);
                    bf16* rowp = dst + (size_t)(row0 + ai * HALF + m * 16) * 384 + 8 * fq;
#pragma unroll
                    for (int bj = 0; bj < 2; ++bj) { const f32x4 v0 = acc[ai][bj][m][0] * r * gv[bj][0], v1 = acc[ai][bj][m][1] * r * gv[bj][1];
                        u32x4 w; w.x = pk2(v0[0], v0[1]); w.y = pk2(v0[2], v0[3]); w.z = pk2(v1[0], v1[1]); w.w = pk2(v1[2], v1[3]);
                        *(u32x4*)(rowp + 32 * bj) = w; }
                }
        } else if (g < 24) {
            const float sc = (g < 18) ? QSCALE : 1.f;
            bf16* dst = (g < 18 ? SQ + (g - 12) * 64 : SK + (g - 18) * 64);
#pragma unroll
            for (int ai = 0; ai < 2; ++ai)
#pragma unroll
                for (int m = 0; m < 4; ++m) { bf16* rowp = dst + (size_t)(row0 + ai * HALF + m * 16) * 384 + 8 * fq;
#pragma unroll
                    for (int bj = 0; bj < 2; ++bj) { const f32x4 v0 = acc[ai][bj][m][0] * sc, v1 = acc[ai][bj][m][1] * sc;
                        u32x4 w; w.x = pk2(v0[0], v0[1]); w.y = pk2(v0[2], v0[3]); w.z = pk2(v1[0], v1[1]); w.w = pk2(v1[2], v1[3]);
                        *(u32x4*)(rowp + 32 * bj) = w; } }
        } else {
            float* dst = SU + (g - 24) * 64;
#pragma unroll
            for (int ai = 0; ai < 2; ++ai)
#pragma unroll
                for (int m = 0; m < 4; ++m) { float* rowp = dst + (size_t)(row0 + ai * HALF + m * 16) * SSMW + 8 * fq;
#pragma unroll
                    for (int bj = 0; bj < 2; ++bj) { *(f32x4*)(rowp + 32 * bj) = acc[ai][bj][m][0]; *(f32x4*)(rowp + 32 * bj + 4) = acc[ai][bj][m][1]; } }
        }
    }
};
struct EpiStoreBf16 {
    static constexpr bool PERM = true;
    bf16* O; int ldc; int pm_off;
    __device__ __forceinline__ void operator()(const Acc& acc, const Unit& u, int wr, int wc, int fr, int fq) const {
        const int row0 = (u.pm - pm_off) * BM + wr * 64 + fr, col0 = u.pn * BM + wc * 32 + 8 * fq;
#pragma unroll
        for (int ai = 0; ai < 2; ++ai)
#pragma unroll
            for (int m = 0; m < 4; ++m) { bf16* rowp = O + (size_t)(row0 + ai * HALF + m * 16) * ldc + col0;
#pragma unroll
                for (int bj = 0; bj < 2; ++bj) { const f32x4 v0 = acc[ai][bj][m][0], v1 = acc[ai][bj][m][1];
                    u32x4 w; w.x = pk2(v0[0], v0[1]); w.y = pk2(v0[2], v0[3]); w.z = pk2(v1[0], v1[1]); w.w = pk2(v1[2], v1[3]);
                    *(u32x4*)(rowp + bj * HALF) = w; } }
    }
};
struct EpiResid {
    static constexpr bool PERM = false;
    const float* base; float* out;
    __device__ __forceinline__ void operator()(const Acc& acc, const Unit& u, int wr, int wc, int fr, int fq) const {
        const int row0 = u.pm * BM + wr * 64 + fr, col0 = u.pn * BM + wc * 32 + 4 * fq;
#pragma unroll
        for (int ai = 0; ai < 2; ++ai)
#pragma unroll
            for (int m = 0; m < 4; ++m) { const size_t off = (size_t)(row0 + ai * HALF + m * 16) * DM + col0;
#pragma unroll
                for (int bj = 0; bj < 2; ++bj)
#pragma unroll
                    for (int n = 0; n < 2; ++n) { const f32x4 b = *(const f32x4*)(base + off + bj * HALF + n * 16); *(f32x4*)(out + off + bj * HALF + n * 16) = b + acc[ai][bj][m][n]; } }
    }
};
struct EpiSwiglu {
    static constexpr bool PERM = true;
    bf16* Hd; int pm_off;
    __device__ __forceinline__ void operator()(const Acc& acc, const Unit& u, int wr, int wc, int fr, int fq) const {
        const int row0 = (u.pm - pm_off) * BM + wr * 64 + fr, col0 = u.pn * HALF + wc * 32 + 8 * fq;
#pragma unroll
        for (int ai = 0; ai < 2; ++ai)
#pragma unroll
            for (int m = 0; m < 4; ++m) { bf16* rowp = Hd + (size_t)(row0 + ai * HALF + m * 16) * DFF + col0;
                float h[8];
#pragma unroll
                for (int n = 0; n < 2; ++n)
#pragma unroll
                    for (int i = 0; i < 4; ++i) { const float a = acc[ai][0][m][n][i], b = acc[ai][1][m][n][i]; h[4 * n + i] = a * frcp(1.f + fexp2(-a * LOG2E)) * b; }
                u32x4 w; w.x = pk2(h[0], h[1]); w.y = pk2(h[2], h[3]); w.z = pk2(h[4], h[5]); w.w = pk2(h[6], h[7]);
                *(u32x4*)rowp = w; }
    }
};
}

#define XB_TMO      128
#define XB_XCNT(j)  (256  + 64 * (j))
#define XB_XSUB(j)  (1280 + 64 * (j))
#define XB_XGEN(j)  (2304 + 64 * (j))
#define XB_TOP      3328
#define XB_TOPGEN   3392
#define XCD_BAR_WORDS 3456
#define XB_SPIN_CAP (1u << 18)
__device__ __forceinline__ unsigned xb_ld(unsigned* p)              { return __hip_atomic_load(p, __ATOMIC_RELAXED, __HIP_MEMORY_SCOPE_AGENT); }
__device__ __forceinline__ unsigned xb_add(unsigned* p, unsigned v) { return __hip_atomic_fetch_add(p, v, __ATOMIC_RELAXED, __HIP_MEMORY_SCOPE_AGENT); }
__device__ __forceinline__ unsigned xb_xcc_id() { return (unsigned)__builtin_amdgcn_s_getreg((3 << 11) | 20) & 0xFu; }
#define XB_SPIN(cond, bar) do { unsigned _sp = 0; while (cond) { __builtin_amdgcn_s_sleep(1); \
    if ((++_sp & 255u) == 0u) { if (xb_ld(&(bar)[XB_TMO])) break; if (_sp > XB_SPIN_CAP) { atomicAdd(&(bar)[XB_TMO], 1u); break; } } } } while (0)
struct XcdBarrier { unsigned* bar; unsigned x; volatile LAS unsigned* st; };
__device__ __forceinline__ XcdBarrier xcd_barrier_post(unsigned* bar, volatile LAS unsigned* st) {
    XcdBarrier b; b.bar = bar; b.x = xb_xcc_id(); b.st = st;
    if (threadIdx.x == 0) (void)xb_add(&bar[XB_XCNT(b.x)], 1u);
    return b;
}
__device__ __forceinline__ void xcd_barrier_complete(unsigned* bar, unsigned x, unsigned& nloc, unsigned& nx) {
    const unsigned G = gridDim.x * gridDim.y * gridDim.z;
    unsigned sum, cnt, mine, sp = 0u;
    for (;;) {
        sum = 0u; cnt = 0u; mine = 0u;
#pragma unroll
        for (unsigned j = 0; j < 16; ++j) { const unsigned c = xb_ld(&bar[XB_XCNT(j)]); sum += c; cnt += (c > 0u) ? 1u : 0u; mine = (j == x) ? c : mine; }
        if (sum == G) break;
        __builtin_amdgcn_s_sleep(1);
        if ((++sp & 255u) == 0u) { if (xb_ld(&bar[XB_TMO])) break; if (sp > XB_SPIN_CAP) { atomicAdd(&bar[XB_TMO], 1u); break; } }
    }
    nloc = mine > 0u ? mine : 1u; nx = cnt > 0u ? cnt : 1u;
}
__device__ __forceinline__ void xcd_barrier(const XcdBarrier& b) {
    asm volatile("s_waitcnt vmcnt(0)" ::: "memory");
    __syncthreads();
    if (threadIdx.x == 0) {
        unsigned* bar = b.bar;
        __builtin_amdgcn_s_waitcnt(0);
        unsigned nloc = b.st[0], nx = b.st[1];
        if (nloc == 0u) { xcd_barrier_complete(bar, b.x, nloc, nx); b.st[0] = nloc; b.st[1] = nx; }
        const unsigned old = xb_add(&bar[XB_XSUB(b.x)], 1u);
        const unsigned gen = old / nloc;
        if (old + 1u == (gen + 1u) * nloc) {
            __builtin_amdgcn_fence(__ATOMIC_RELEASE, "agent");
            asm volatile("s_waitcnt vmcnt(0)" ::: "memory");
            const unsigned og = xb_add(&bar[XB_TOP], 1u);
            const unsigned tg = og / nx;
            if (og + 1u == (tg + 1u) * nx) xb_add(&bar[XB_TOPGEN], 1u);
            else XB_SPIN(xb_ld(&bar[XB_TOPGEN]) == tg, bar);
            __builtin_amdgcn_fence(__ATOMIC_ACQUIRE, "agent");
            xb_add(&bar[XB_XGEN(b.x)], 1u);
            asm volatile("s_waitcnt vmcnt(0)" ::: "memory");
        } else {
            XB_SPIN(xb_ld(&bar[XB_XGEN(b.x)]) == gen, bar);
            __builtin_amdgcn_fence(__ATOMIC_ACQUIRE, "agent");
            asm volatile("s_waitcnt vmcnt(0)" ::: "memory");
        }
    }
    __syncthreads();
}

struct Args { const float* in[26]; float* out; unsigned char* ws; int ph_lo, ph_hi, li, pad; };
struct Frame {
    LAS unsigned char* lds;
    gu32* ctl;
    int tid, lane, wave, vcu, G;
    const float* const* in;
    unsigned char* ws; float* out;
};
#define IN_X 0
#define IN_ATTN_NORM 1
#define IN_FFN_NORM 2
#define IN_W_IN 3
#define IN_B_FORGET 4
#define IN_FQN 5
#define IN_FKN 6
#define IN_A_RE 7
#define IN_A_IM 8
#define IN_LOG_DT 9
#define IN_B_RE 10
#define IN_B_IM 11
#define IN_C_RE 12
#define IN_C_IM 13
#define IN_SSM_D 14
#define IN_W_GLU 15
#define IN_B_GLU 16
#define IN_OUT_NORM 17
#define IN_W_OUT 18
#define IN_DGATE 19
#define IN_DUP 20
#define IN_DDOWN 21
#define IN_ROUTER 22
#define IN_MGATE 23
#define IN_MUP 24
#define IN_MDOWN 25

__device__ __forceinline__ int map_row(int kind, int n) {
    if (kind == 0) return n;
    if (kind == 2) return 256 * (n >> 7) + (n & 127);
    if (kind == 3) return 256 * (n >> 7) + 128 + (n & 127);
    int j;
    if (n < 768) j = n;
    else if (n < 1152) return NQK + (n - 768);
    else if (n < 1158) return -1;
    else if (n < 1542) j = 768 + (n - 1158);
    else if (n < 1926) j = 1152 + (n - 1542);
    else if (n < 2310) return NQK + 384 + (n - 1926);
    else j = 1536 + (n - 2310);
    return (j & ~255) + 128 * ((j >> 5) & 1) + 32 * ((j >> 6) & 3) + (j & 31);
}
__device__ __forceinline__ void tr_item(const float* W, int K, int N, bf16* WT, int kind, LAS float* scr, int item, int lane) {
    const int nblk = (N + 31) >> 5, kb = item / nblk, nb = item - kb * nblk, k0 = 64 * kb, n0 = 32 * nb;
    const int nn = n0 + (lane & 31);
    float tv[32];
#pragma unroll
    for (int i = 0; i < 32; ++i) { const int kk = 2 * i + (lane >> 5); tv[i] = (nn < N) ? *(const GAS float*)(W + (size_t)(k0 + kk) * N + nn) : 0.f; }
#pragma unroll
    for (int i = 0; i < 32; ++i) { const int kk = 2 * i + (lane >> 5); scr[kk * 33 + (lane & 31)] = tv[i]; }
    LDS_WAIT(); asm volatile("" ::: "memory");
    const int c = lane & 7;
#pragma unroll
    for (int j = 0; j < 4; ++j) { const int nl = (lane >> 3) + 8 * j; const int n = n0 + nl; const LAS float* s = scr + (8 * c) * 33 + nl;
        const int dr = (n < N) ? map_row(kind, n) : -1;
        if (dr >= 0) { u32x4 o; o.x = pk2(s[0 * 33], s[1 * 33]); o.y = pk2(s[2 * 33], s[3 * 33]); o.z = pk2(s[4 * 33], s[5 * 33]); o.w = pk2(s[6 * 33], s[7 * 33]);
            *(u32x4*)(WT + (size_t)dr * K + k0 + 8 * c) = o; } }
    LDS_WAIT(); asm volatile("" ::: "memory");
}
__device__ __forceinline__ void p0_prologue(const Frame& F, const Args& A) {
    if (blockIdx.x == 0 && F.tid < 27) ((const void**)(F.ws + WS_PTRS))[F.tid] = (F.tid < 26) ? (const void*)A.in[F.tid] : (const void*)A.out;
    LAS float* scr = (LAS float*)(F.lds + F.wave * 16384);
    const int gw = F.vcu * 8 + F.wave, NGW = F.G * 8;
    unsigned char* ws = F.ws;
    constexpr int I_IN = 16 * 81, I_OUT = 16 * 32, I_GLU = 4 * 8, I_FF = 1792;
    constexpr int S0 = NL * I_IN, S1 = S0 + NL * I_OUT, S2 = S1 + NL * I_GLU, S3 = S2 + 2 * I_FF  , S4 = S3 + 2 * I_FF  , S5 = S4 + 2 * I_FF  ,
                  S6 = S5 + 16 * I_FF  , S7 = S6 + 16 * I_FF  , S8 = S7 + 16 * I_FF  ;
    for (int it = gw; it < S8; it += NGW) {
        if (it < S0) { const int l = it / I_IN, r = it - l * I_IN; tr_item(A.in[IN_W_IN] + (size_t)l * DM * PROJW, DM, PROJW, (bf16*)(ws + WS_WIN) + (size_t)l * 2560 * DM, 1, scr, r, F.lane); }
        else if (it < S1) { const int q = it - S0, l = q / I_OUT, r = q - l * I_OUT; tr_item(A.in[IN_W_OUT] + (size_t)l * DM * DM, DM, DM, (bf16*)(ws + WS_WOUT) + (size_t)l * DM * DM, 0, scr, r, F.lane); }
        else if (it < S2) { const int q = it - S1, l = q / I_GLU, r = q - l * I_GLU; tr_item(A.in[IN_W_GLU] + (size_t)l * 65536, 256, 256, (bf16*)(ws + WS_WGLU) + (size_t)l * 65536, 0, scr, r, F.lane); }
        else if (it < S3) { const int q = it - S2, l = q / I_FF, r = q - l * I_FF; tr_item(A.in[IN_DGATE] + (size_t)l * DM * DFF, DM, DFF, (bf16*)(ws + WS_DGU) + (size_t)l * 7168 * DM, 2, scr, r, F.lane); }
        else if (it < S4) { const int q = it - S3, l = q / I_FF, r = q - l * I_FF; tr_item(A.in[IN_DUP] + (size_t)l * DM * DFF, DM, DFF, (bf16*)(ws + WS_DGU) + (size_t)l * 7168 * DM, 3, scr, r, F.lane); }
        else if (it < S5) { const int q = it - S4, l = q / I_FF, r = q - l * I_FF; tr_item(A.in[IN_DDOWN] + (size_t)l * DFF * DM, DFF, DM, (bf16*)(ws + WS_DDN) + (size_t)l * DM * DFF, 0, scr, r, F.lane); }
        else if (it < S6) { const int q = it - S5, l = q / I_FF, r = q - l * I_FF; tr_item(A.in[IN_MGATE] + (size_t)l * DM * DFF, DM, DFF, (bf16*)(ws + WS_MGU) + (size_t)l * 7168 * DM, 2, scr, r, F.lane); }
        else if (it < S7) { const int q = it - S6, l = q / I_FF, r = q - l * I_FF; tr_item(A.in[IN_MUP] + (size_t)l * DM * DFF, DM, DFF, (bf16*)(ws + WS_MGU) + (size_t)l * 7168 * DM, 3, scr, r, F.lane); }
        else { const int q = it - S7, l = q / I_FF, r = q - l * I_FF; tr_item(A.in[IN_MDOWN] + (size_t)l * DFF * DM, DFF, DM, (bf16*)(ws + WS_MDN) + (size_t)l * DM * DFF, 0, scr, r, F.lane); }
    }
    const int gt = F.vcu * 512 + F.tid;
    if (gt < NL * NG * NS) {
        const int n = gt & 63, lg = gt >> 6, g = lg & 15;
        const double are = (double)A.in[IN_A_RE][gt], aim = (double)A.in[IN_A_IM][gt];
        const double dt = exp((double)A.in[IN_LOG_DT][lg]);
        const double mag = exp(dt * are), ang = dt * aim;
        const double abr = mag * cos(ang), abi = mag * sin(ang);
        const double magL = exp((double)CH * dt * are), angL = (double)CH * ang;
        const double den = are * are + aim * aim, nr = abr - 1.0, ni = abi;
        const double cr = (nr * are + ni * aim) / den, ci = (ni * are - nr * aim) / den;
        float* tb = (float*)(ws + WS_S5T) + (size_t)lg * 2304;
        tb[n] = (float)abr; tb[64 + n] = (float)abi; tb[128 + n] = (float)(magL * cos(angL)); tb[192 + n] = (float)(magL * sin(angL));
        const float* bre = A.in[IN_B_RE] + (size_t)gt * SG; const float* bim = A.in[IN_B_IM] + (size_t)gt * SG;
        (void)g;
#pragma unroll
        for (int c = 0; c < SG; ++c) { const double br = bre[c], bi = bim[c]; tb[256 + n * 16 + c] = (float)(cr * br - ci * bi); tb[1280 + n * 16 + c] = (float)(cr * bi + ci * br); }
    }
}

template <int MODE>
__device__ __forceinline__ void norm_phase(const Frame& F, int layer, bool combine, const float* xsrc) {
    unsigned char* ws = F.ws;
    LAS float* wl = (LAS float*)F.lds;
    LAS int* rte = (LAS int*)(F.lds + 32768);
    if (MODE == 0) { const float* w = F.in[IN_W_IN] + (size_t)layer * DM * PROJW + 1152;
        for (int idx = F.tid; idx < 6 * DM; idx += 512) { const int k = idx / 6, h = idx - 6 * k; wl[h * DM + k] = w[(size_t)k * PROJW + h]; } }
    if (MODE == 2) { const float* w = F.in[IN_ROUTER] + (size_t)(layer >> 1) * DM * NE;
        for (int idx = F.tid; idx < NE * DM; idx += 512) { const int k = idx >> 3, e = idx & 7; wl[e * DM + k] = w[idx]; } }
    if (MODE == 0 || MODE == 2) __syncthreads();
    const float* gain = (MODE == 0 ? F.in[IN_ATTN_NORM] : F.in[IN_FFN_NORM]) + layer * DM;
    f32x4 gv[4];
    if (MODE != 3) {
#pragma unroll
        for (int j = 0; j < 4; ++j) gv[j] = *(const f32x4*)(gain + 4 * F.lane + 256 * j);
    }
    const bf16* Y = (const bf16*)(ws + WS_R2);
    for (int i = 0; i < 16; ++i) {
        const int li = F.wave + 8 * i, tok = 128 * F.vcu + li;
        f32x4 v[4];
#pragma unroll
        for (int j = 0; j < 4; ++j) v[j] = *(const f32x4*)(xsrc + (size_t)tok * DM + 4 * F.lane + 256 * j);
        if (combine) {
            const int2 tr = *(const int2*)(ws + WS_TOKROW + (size_t)tok * 8); const f32x2 rw = *(const f32x2*)(ws + WS_RTW + (size_t)tok * 8);
#pragma unroll
            for (int j = 0; j < 4; ++j) {
                const u32x2 a = *(const u32x2*)(Y + (size_t)tr.x * DM + 4 * F.lane + 256 * j), b = *(const u32x2*)(Y + (size_t)tr.y * DM + 4 * F.lane + 256 * j);
                v[j][0] += rw.x * bf2f((unsigned short)(a.x & 0xffff)) + rw.y * bf2f((unsigned short)(b.x & 0xffff));
                v[j][1] += rw.x * bf2f((unsigned short)(a.x >> 16)) + rw.y * bf2f((unsigned short)(b.x >> 16));
                v[j][2] += rw.x * bf2f((unsigned short)(a.y & 0xffff)) + rw.y * bf2f((unsigned short)(b.y & 0xffff));
                v[j][3] += rw.x * bf2f((unsigned short)(a.y >> 16)) + rw.y * bf2f((unsigned short)(b.y >> 16));
                *(f32x4*)(F.out + (size_t)tok * DM + 4 * F.lane + 256 * j) = v[j];
            }
        }
        if (MODE == 3) continue;
        float ss = 0.f;
#pragma unroll
        for (int j = 0; j < 4; ++j) ss += (v[j][0] * v[j][0] + v[j][1] * v[j][1]) + (v[j][2] * v[j][2] + v[j][3] * v[j][3]);
        const float r = __builtin_amdgcn_rsqf(wave_sum(ss) * (1.f / DM) + EPS);
        bf16* xn = (bf16*)(ws + WS_XN) + (size_t)tok * DM;
#pragma unroll
        for (int j = 0; j < 4; ++j) { v[j] = v[j] * r * gv[j]; u32x2 w; w.x = pk2(v[j][0], v[j][1]); w.y = pk2(v[j][2], v[j][3]); *(u32x2*)(xn + 4 * F.lane + 256 * j) = w; }
        if (MODE == 0) {
            float fg[6];
#pragma unroll
            for (int h = 0; h < 6; ++h) { float s = 0.f;
#pragma unroll
                for (int j = 0; j < 4; ++j) { const f32x4 w = *(const LAS f32x4*)(wl + h * DM + 4 * F.lane + 256 * j); s += (v[j][0] * w[0] + v[j][1] * w[1]) + (v[j][2] * w[2] + v[j][3] * w[3]); }
                fg[h] = wave_sum(s); }
            if (F.lane < 6) {
                float x = fg[0];
#pragma unroll
                for (int h = 1; h < 6; ++h) x = (F.lane == h) ? fg[h] : x;
                x += F.in[IN_B_FORGET][layer * 6 + F.lane];
                const float lf = fminf(x, 0.f) - log1pf(expf(-fabsf(x)));
                const int b = tok / SEQ, s = tok - b * SEQ;
                ((float*)(ws + WS_LOGF))[(size_t)(b * 6 + F.lane) * SEQ + s] = lf;
            }
        }
        if (MODE == 2) {
            float lg[8];
#pragma unroll
            for (int e = 0; e < 8; ++e) { float s = 0.f;
#pragma unroll
                for (int j = 0; j < 4; ++j) { const f32x4 w = *(const LAS f32x4*)(wl + e * DM + 4 * F.lane + 256 * j); s += (v[j][0] * w[0] + v[j][1] * w[1]) + (v[j][2] * w[2] + v[j][3] * w[3]); }
                lg[e] = wave_sum(s); }
            int e1 = 0; float v1 = lg[0];
#pragma unroll
            for (int e = 1; e < 8; ++e) if (lg[e] > v1) { v1 = lg[e]; e1 = e; }
            int e2 = -1; float v2 = -INFINITY;
#pragma unroll
            for (int e = 0; e < 8; ++e) if (e != e1 && lg[e] > v2) { v2 = lg[e]; e2 = e; }
            const float w1 = 1.f / (1.f + expf(v2 - v1));
            if (F.lane == 0) { *(int2*)(ws + WS_RTE + (size_t)tok * 8) = make_int2(e1, e2); *(f32x2*)(ws + WS_RTW + (size_t)tok * 8) = (f32x2){w1, 1.f - w1}; rte[2 * li] = e1; rte[2 * li + 1] = e2; }
        }
    }
    if (MODE == 2) {
        __syncthreads();
        if (F.wave == 0) {
            const int a1 = rte[2 * F.lane], a2 = rte[2 * F.lane + 1], b1 = rte[2 * (64 + F.lane)], b2 = rte[2 * (64 + F.lane) + 1];
            const unsigned long long lt = (1ull << F.lane) - 1ull;
            int ra1 = 0, ra2 = 0, rb1 = 0, rb2 = 0, mycnt = 0;
#pragma unroll
            for (int e = 0; e < 8; ++e) {
                const unsigned long long m0 = __ballot(a1 == e || a2 == e), m1 = __ballot(b1 == e || b2 == e);
                const int r0 = __popcll(m0 & lt), r1 = __popcll(m0) + __popcll(m1 & lt);
                if (a1 == e) ra1 = r0; if (a2 == e) ra2 = r0; if (b1 == e) rb1 = r1; if (b2 == e) rb2 = r1;
                if (F.lane == e) mycnt = __popcll(m0) + __popcll(m1);
            }
            *(int2*)(ws + WS_LRANK + (size_t)(128 * F.vcu + F.lane) * 8) = make_int2(ra1, ra2);
            *(int2*)(ws + WS_LRANK + (size_t)(128 * F.vcu + 64 + F.lane) * 8) = make_int2(rb1, rb2);
            if (F.lane < 8) ((int*)(ws + WS_WGCNT))[F.vcu * 8 + F.lane] = mycnt;
        }
    }
}

__device__ __forceinline__ void moe_gather_phase(const Frame& F) {
    unsigned char* ws = F.ws;
    LAS int* sh = (LAS int*)F.lds;
    const int* wc = (const int*)(ws + WS_WGCNT);
    {
        const int e = F.wave; int tot = 0, pre = 0;
#pragma unroll
        for (int j = 0; j < 4; ++j) { const int w = F.lane + 64 * j; const int c = wc[w * 8 + e]; tot += c; pre += (w < F.vcu) ? c : 0; }
#pragma unroll
        for (int o = 1; o < 64; o <<= 1) { tot += __shfl_xor(tot, o); pre += __shfl_xor(pre, o); }
        if (F.lane == 0) { sh[e] = tot; sh[8 + e] = pre; }
    }
    __syncthreads();
    if (F.tid == 0) { int b = 0; for (int e = 0; e < 8; ++e) { sh[16 + e] = b; b += (sh[e] + 255) & ~255; } sh[24] = b;
        if (F.vcu == 0) { int* mb = (int*)(ws + WS_MOEB); for (int e = 0; e < 9; ++e) mb[e] = sh[16 + e] >> 8; } }
    __syncthreads();
    const bf16* XN = (const bf16*)(ws + WS_XN); bf16* AG = (bf16*)(ws + WS_R2);
    for (int i = 0; i < 16; ++i) {
        const int tok = 128 * F.vcu + F.wave + 8 * i;
        const int2 ee = *(const int2*)(ws + WS_RTE + (size_t)tok * 8), rk = *(const int2*)(ws + WS_LRANK + (size_t)tok * 8);
        const int r1 = sh[16 + ee.x] + sh[8 + ee.x] + rk.x, r2 = sh[16 + ee.y] + sh[8 + ee.y] + rk.y;
        const u32x4* src = (const u32x4*)(XN + (size_t)tok * DM);
        const u32x4 a = src[F.lane], b = src[64 + F.lane];
        u32x4* d1 = (u32x4*)(AG + (size_t)r1 * DM); u32x4* d2 = (u32x4*)(AG + (size_t)r2 * DM);
        d1[F.lane] = a; d1[64 + F.lane] = b; d2[F.lane] = a; d2[64 + F.lane] = b;
        if (F.lane == 0) *(int2*)(ws + WS_TOKROW + (size_t)tok * 8) = make_int2(r1, r2);
    }
}

__device__ __forceinline__ void cumsum_phase(const Frame& F) {
    if (F.vcu >= 24) return;
    unsigned char* ws = F.ws;
    LAS float* sh = (LAS float*)F.lds;
    const float* lf = (const float*)(ws + WS_LOGF) + (size_t)F.vcu * SEQ + 16 * F.tid;
    float v[16];
#pragma unroll
    for (int j = 0; j < 4; ++j) { const f32x4 x = *(const f32x4*)(lf + 4 * j); v[4 * j] = x[0]; v[4 * j + 1] = x[1]; v[4 * j + 2] = x[2]; v[4 * j + 3] = x[3]; }
#pragma unroll
    for (int j = 1; j < 16; ++j) v[j] += v[j - 1];
    float run = v[15];
#pragma unroll
    for (int o = 1; o < 64; o <<= 1) { const float t = __shfl_up(run, o); if (F.lane >= o) run += t; }
    if (F.lane == 63) sh[F.wave] = run;
    __syncthreads();
    float base = run - v[15];
    for (int w = 0; w < F.wave; ++w) base += sh[w];
    float* c2 = (float*)(ws + WS_C2) + (size_t)F.vcu * SEQ + 16 * F.tid;
#pragma unroll
    for (int j = 0; j < 4; ++j) *(f32x4*)(c2 + 4 * j) = (f32x4){(base + v[4 * j]) * LOG2E, (base + v[4 * j + 1]) * LOG2E, (base + v[4 * j + 2]) * LOG2E, (base + v[4 * j + 3]) * LOG2E};
    __syncthreads();
}

__device__ __forceinline__ bf16x8 pack8(const f32x16& p, int s) {
    u32x4 w; w.x = pk2(p[8 * s], p[8 * s + 1]); w.y = pk2(p[8 * s + 2], p[8 * s + 3]); w.z = pk2(p[8 * s + 4], p[8 * s + 5]); w.w = pk2(p[8 * s + 6], p[8 * s + 7]);
    return __builtin_bit_cast(bf16x8, w);
}
__device__ __forceinline__ float sumsq8(bf16x8 v) { float s = 0.f;
#pragma unroll
    for (int j = 0; j < 8; ++j) { const float f = bf2f((unsigned short)v[j]); s += f * f; } return s; }

constexpr int AT_R = 4, AT_SLOT = 18432, AT_FLAGS = AT_R * AT_SLOT;
template <bool FOX>
__device__ __forceinline__ void attn_dma(LAS unsigned char* lds, int slot, const GAS char* Kh, const GAS char* Vh, const GAS float* c2, unsigned kdo, unsigned vdo, int kt, int wave, int lane) {
    const int ktc = kt > 0 ? kt : 0;
    LAS unsigned char* sb = lds + slot * AT_SLOT;
    __builtin_amdgcn_global_load_lds((const unsigned*)(Kh + (size_t)(64 * ktc) * 768 + kdo), (LAS unsigned*)(sb + 1024 * wave), 16, 0, 0);
    __builtin_amdgcn_global_load_lds((const unsigned*)(Vh + (size_t)(64 * ktc) * 2 + vdo), (LAS unsigned*)(sb + 8192 + 1024 * wave), 16, 0, 0);
    if (FOX) __builtin_amdgcn_global_load_lds((const unsigned*)(c2 + 64 * ktc + lane), (LAS unsigned*)(sb + 16384 + 256 * wave), 4, 0, 0);
}
template <bool FOX>
__device__ __forceinline__ void attn_unit(const Frame& F, int layer, int b, int h, int QB, float kbound) {
    unsigned char* ws = F.ws;
    const int lane = F.lane, q = lane & 31, hh = lane >> 5, w = F.wave;
    const size_t tok0 = (size_t)b * SEQ; const int q0 = 256 * QB + 32 * w, qa = q0 + q;
    const GAS bf16* Qb = (const GAS bf16*)(ws + (FOX ? WS_FQ : WS_SQ)); const GAS bf16* Kb = (const GAS bf16*)(ws + (FOX ? WS_FK : WS_SK));
    const GAS char* Kh = (const GAS char*)(Kb + tok0 * 384 + h * 64);
    const GAS char* Vh = (const GAS char*)((const GAS bf16*)(ws + WS_VT) + (size_t)((FOX ? 0 : 384) + h * 64) * T + tok0);
    const GAS float* c2 = (const GAS float*)(ws + WS_C2) + (size_t)(b * 6 + h) * SEQ;
    const int drow = 8 * w + (lane >> 3), dch = (lane & 7) ^ ((drow >> 1) & 7);
    const unsigned kdo = (unsigned)(drow * 768 + 16 * dch), vdo = (unsigned)drow * (unsigned)(2 * T) + (unsigned)(16 * dch);
    const int krow = 32 * ((q >> 2) & 1) + 8 * (q >> 4) + 4 * ((q >> 3) & 1) + (q & 3), ksw = (krow >> 1) & 7, vsw = (q >> 1) & 7;
    unsigned kro[4], vro[2][2];
#pragma unroll
    for (int ks = 0; ks < 4; ++ks) kro[ks] = (unsigned)(krow * 128 + 16 * ((2 * ks + hh) ^ ksw));
#pragma unroll
    for (int blk = 0; blk < 2; ++blk)
#pragma unroll
        for (int sx = 0; sx < 2; ++sx) vro[blk][sx] = (unsigned)(8192 + q * 128 + 16 * ((4 * hh + 2 * blk + sx) ^ vsw));
    bf16x8 qf[4];
#pragma unroll
    for (int ks = 0; ks < 4; ++ks) qf[ks] = *(const GAS bf16x8*)(Qb + (tok0 + qa) * 384 + h * 64 + 16 * ks + 8 * hh);
    float ct = 0.f, qk = 0.f;
    if (FOX) { ct = c2[qa]; float qs = sumsq8(qf[0]) + sumsq8(qf[1]) + sumsq8(qf[2]) + sumsq8(qf[3]); qs += __shfl_xor(qs, 32); qk = sqrtf(qs) * kbound; }
    float m = -INFINITY, l = 0.f, carry = 1.f;
    f32x16 o0, o1;
#pragma unroll
    for (int r = 0; r < 16; ++r) { o0[r] = 0.f; o1[r] = 0.f; }
    const int ktmax = 4 * QB + 3, ktd = q0 >> 6;
    LAS int* flags = (LAS int*)(F.lds + AT_FLAGS);
    bool mydone = false;
    attn_dma<FOX>(F.lds, 0, Kh, Vh, c2, kdo, vdo, ktmax, w, lane);
    attn_dma<FOX>(F.lds, 1, Kh, Vh, c2, kdo, vdo, ktmax - 1, w, lane);
    attn_dma<FOX>(F.lds, 2, Kh, Vh, c2, kdo, vdo, ktmax - 2, w, lane);
    int slot = 0;
    for (int i = 0;; ++i) {
        const int kt = ktmax - i;
        if (FOX) asm volatile("s_waitcnt vmcnt(6)" ::: "memory"); else asm volatile("s_waitcnt vmcnt(4)" ::: "memory");
        asm volatile("s_waitcnt lgkmcnt(0)" ::: "memory");
        __builtin_amdgcn_s_barrier();
        asm volatile("" ::: "memory");
        if (i > 0) {
            const LAS int* fl = flags + 8 * ((i - 1) & 1);
            const u32x4 fa = *(const LAS u32x4*)fl, fb = *(const LAS u32x4*)(fl + 4);
            if ((fa.x & fa.y & fa.z & fa.w & fb.x & fb.y & fb.z & fb.w) != 0u) break;
        }
        { int ns = slot + 3; ns = ns >= AT_R ? ns - AT_R : ns; attn_dma<FOX>(F.lds, ns, Kh, Vh, c2, kdo, vdo, kt - 3, w, lane); }
        if (kt <= ktd && !mydone) {
            const LAS unsigned char* sb = F.lds + slot * AT_SLOT;
            f32x16 p0, p1;
#pragma unroll
            for (int r = 0; r < 16; ++r) { p0[r] = 0.f; p1[r] = 0.f; }
#pragma unroll
            for (int ks = 0; ks < 4; ++ks) {
                const bf16x8 k0 = *(const LAS bf16x8*)(sb + kro[ks]), k1 = *(const LAS bf16x8*)(sb + kro[ks] + 2048);
                p0 = __builtin_amdgcn_mfma_f32_32x32x16_bf16(k0, qf[ks], p0, 0, 0, 0); p1 = __builtin_amdgcn_mfma_f32_32x32x16_bf16(k1, qf[ks], p1, 0, 0, 0);
            }
            const int kbase = 64 * kt + 32 * hh;
            float cfirst = 0.f;
            if (FOX) {
                const LAS float* cl = (const LAS float*)(sb + 16384 + 256 * w);
                const LAS float* cp = cl + 32 * hh;
#pragma unroll
                for (int j = 0; j < 4; ++j) { const f32x4 ca = *(const LAS f32x4*)(cp + 4 * j), cb = *(const LAS f32x4*)(cp + 16 + 4 * j);
#pragma unroll
                    for (int ii = 0; ii < 4; ++ii) { p0[4 * j + ii] += ct - ca[ii]; p1[4 * j + ii] += ct - cb[ii]; } }
                cfirst = cl[0];
                if (kt == ktd) {
#pragma unroll
                    for (int r = 0; r < 16; ++r) { if (kbase + r > qa) p0[r] = -INFINITY; if (kbase + 16 + r > qa) p1[r] = -INFINITY; }
                }
                float tm = fmaxf(p0[0], p1[0]);
#pragma unroll
                for (int r = 1; r < 16; ++r) tm = fmaxf(tm, fmaxf(p0[r], p1[r]));
                tm = fmaxf(tm, __shfl_xor(tm, 32));
                const float mn = fmaxf(m, tm), alpha = fexp2(m - mn);
                float ls = 0.f;
#pragma unroll
                for (int r = 0; r < 16; ++r) { p0[r] = fexp2(p0[r] - mn); p1[r] = fexp2(p1[r] - mn); ls += p0[r] + p1[r]; }
                l = l * alpha + ls; m = mn;
#pragma unroll
                for (int r = 0; r < 16; ++r) { o0[r] *= alpha; o1[r] *= alpha; }
            } else {
                float run = 1.f;
                if (kt == ktd) {
#pragma unroll
                    for (int r = 15; r >= 0; --r) { const float e = fexp2(fminf(p1[r], 80.f)); float t = frcp(1.f + e); float bt = e * t; if (kbase + 16 + r >= qa) { bt = 0.f; t = 1.f; } p1[r] = bt * run; run *= t; }
#pragma unroll
                    for (int r = 15; r >= 0; --r) { const float e = fexp2(fminf(p0[r], 80.f)); float t = frcp(1.f + e); float bt = e * t; if (kbase + r >= qa) { bt = 0.f; t = 1.f; } p0[r] = bt * run; run *= t; }
                } else {
#pragma unroll
                    for (int r = 15; r >= 0; --r) { const float e = fexp2(fminf(p1[r], 80.f)); const float t = frcp(1.f + e); p1[r] = e * t * run; run *= t; }
#pragma unroll
                    for (int r = 15; r >= 0; --r) { const float e = fexp2(fminf(p0[r], 80.f)); const float t = frcp(1.f + e); p0[r] = e * t * run; run *= t; }
                }
                const float other = __shfl_xor(run, 32);
                const float lc = carry * (hh == 0 ? other : 1.f);
#pragma unroll
                for (int r = 0; r < 16; ++r) { p0[r] *= lc; p1[r] *= lc; }
                carry *= run * other;
            }
            const bf16x8 pb00 = pack8(p0, 0), pb01 = pack8(p0, 1), pb10 = pack8(p1, 0), pb11 = pack8(p1, 1);
            {
                const bf16x8 v00 = *(const LAS bf16x8*)(sb + vro[0][0]), v01 = *(const LAS bf16x8*)(sb + vro[0][1]), v10 = *(const LAS bf16x8*)(sb + vro[1][0]), v11 = *(const LAS bf16x8*)(sb + vro[1][1]);
                o0 = __builtin_amdgcn_mfma_f32_32x32x16_bf16(v00, pb00, o0, 0, 0, 0); o0 = __builtin_amdgcn_mfma_f32_32x32x16_bf16(v01, pb01, o0, 0, 0, 0);
                o0 = __builtin_amdgcn_mfma_f32_32x32x16_bf16(v10, pb10, o0, 0, 0, 0); o0 = __builtin_amdgcn_mfma_f32_32x32x16_bf16(v11, pb11, o0, 0, 0, 0);
            }
            {
                const bf16x8 v00 = *(const LAS bf16x8*)(sb + vro[0][0] + 4096), v01 = *(const LAS bf16x8*)(sb + vro[0][1] + 4096), v10 = *(const LAS bf16x8*)(sb + vro[1][0] + 4096), v11 = *(const LAS bf16x8*)(sb + vro[1][1] + 4096);
                o1 = __builtin_amdgcn_mfma_f32_32x32x16_bf16(v00, pb00, o1, 0, 0, 0); o1 = __builtin_amdgcn_mfma_f32_32x32x16_bf16(v01, pb01, o1, 0, 0, 0);
                o1 = __builtin_amdgcn_mfma_f32_32x32x16_bf16(v10, pb10, o1, 0, 0, 0); o1 = __builtin_amdgcn_mfma_f32_32x32x16_bf16(v11, pb11, o1, 0, 0, 0);
            }
            if (kt == 0) mydone = true;
            else if (FOX) { const float ub = qk + ct - cfirst; mydone = __all(ub < m - 50.f) != 0; }
            else mydone = __all(carry < 7.8e-31f) != 0;
        }
        if (lane == 0) flags[8 * (i & 1) + w] = mydone ? 1 : 0;
        slot = slot + 1 >= AT_R ? 0 : slot + 1;
    }
    asm volatile("s_waitcnt vmcnt(0)" ::: "memory");
    float inv = 1.f;
    if (FOX) { const float lt = l + __shfl_xor(l, 32); inv = 1.f / lt; }
    float ss = 0.f;
#pragma unroll
    for (int r = 0; r < 16; ++r) { o0[r] *= inv; o1[r] *= inv; ss += o0[r] * o0[r] + o1[r] * o1[r]; }
    ss += __shfl_xor(ss, 32);
    const float rn = __builtin_amdgcn_rsqf(ss * (1.f / 64.f) + EPS);
    const int colb = (FOX ? 0 : 384) + h * 64 + 4 * hh;
    const GAS float* on = (const GAS float*)(F.in[IN_OUT_NORM] + layer * DM + colb);
    GAS bf16* dst = (GAS bf16*)(ws + WS_MIX) + (tok0 + qa) * DM + colb;
#pragma unroll
    for (int g = 0; g < 4; ++g) {
        const f32x4 g0 = *(const GAS f32x4*)(on + 8 * g), g1 = *(const GAS f32x4*)(on + 32 + 8 * g);
        u32x2 w0, w1;
        w0.x = pk2(o0[4 * g] * rn * g0[0], o0[4 * g + 1] * rn * g0[1]); w0.y = pk2(o0[4 * g + 2] * rn * g0[2], o0[4 * g + 3] * rn * g0[3]);
        w1.x = pk2(o1[4 * g] * rn * g1[0], o1[4 * g + 1] * rn * g1[1]); w1.y = pk2(o1[4 * g + 2] * rn * g1[2], o1[4 * g + 3] * rn * g1[3]);
        *(GAS u32x2*)(dst + 8 * g) = w0; *(GAS u32x2*)(dst + 32 + 8 * g) = w1;
    }
    __syncthreads();
}

__device__ __forceinline__ void s5_chunk_state(const Frame& F, int layer, int b, int g, int k) {
    unsigned char* ws = F.ws;
    LAS float* us = (LAS float*)(F.lds + F.wave * 4096);
    const float* tb = (const float*)(ws + WS_S5T) + (size_t)(layer * NG + g) * 2304;
    const int n = F.lane;
    const float ar = tb[n], ai = tb[64 + n];
    f32x4 br[4], bi[4];
#pragma unroll
    for (int j = 0; j < 4; ++j) { br[j] = *(const f32x4*)(tb + 256 + n * 16 + 4 * j); bi[j] = *(const f32x4*)(tb + 1280 + n * 16 + 4 * j); }
    const float* up = (const float*)(ws + WS_SU) + ((size_t)b * SEQ + 64 * k + F.lane) * SSMW + 16 * g;
#pragma unroll
    for (int j = 0; j < 4; ++j) *(LAS f32x4*)(us + F.lane * 16 + 4 * j) = *(const f32x4*)(up + 4 * j);
    LDS_WAIT();
    float hr = 0.f, hi = 0.f;
    for (int t = 0; t < CH; ++t) {
        float sr = 0.f, si = 0.f;
#pragma unroll
        for (int j = 0; j < 4; ++j) { const f32x4 u = *(const LAS f32x4*)(us + t * 16 + 4 * j);
            sr += (br[j][0] * u[0] + br[j][1] * u[1]) + (br[j][2] * u[2] + br[j][3] * u[3]); si += (bi[j][0] * u[0] + bi[j][1] * u[1]) + (bi[j][2] * u[2] + bi[j][3] * u[3]); }
        const float nr = ar * hr - ai * hi + sr, ni = ar * hi + ai * hr + si; hr = nr; hi = ni;
    }
    ((f32x2*)(ws + WS_SEND))[((size_t)(b * NG + g) * NCH + k) * 64 + n] = (f32x2){hr, hi};
    LDS_WAIT();
}

__device__ __forceinline__ void attn_phase(const Frame& F, int layer) {
    const float kg = fabsf(F.in[IN_FKN][layer * 64 + F.lane]);
    const float kbound = wave_max(kg) * 8.f * 1.01f;
    gu32* head = F.ctl + CW_QHEAD + 64 * layer;
    LAS int* qslot = (LAS int*)(F.lds + AT_FLAGS + 64);
    constexpr int NATT = 24 * 32;
    for (;;) {
        if (F.tid == 0) qslot[0] = (int)__hip_atomic_fetch_add(head, 1u, RLX_AGENT);
        __syncthreads();
        const int idx = __builtin_amdgcn_readfirstlane(qslot[0]);
        __syncthreads();
        if (idx >= 2 * NATT + NB * NG * NCH / 8) break;
        if (idx < 2 * NATT) {
            const int j = (idx < NATT) ? idx : idx - NATT;
            const int bh = j % 24, QB = 31 - j / 24;
            if (idx < NATT) attn_unit<true>(F, layer, bh / 6, bh % 6, QB, kbound);
            else attn_unit<false>(F, layer, bh / 6, bh % 6, QB, kbound);
        } else {
            const int j = (idx - 2 * NATT) * 8 + F.wave; s5_chunk_state(F, layer, j >> 11, (j >> 7) & 15, j & 127);
        }
    }
}

__device__ __forceinline__ float gelu_tanh(float x) { const float u = 0.7978845608028654f * (x + 0.044715f * x * x * x); return x * frcp(1.f + fexp2(-2.f * LOG2E * u)); }
constexpr int S5_WLDS = 12800, S5_HS = 132, S5_GOFF = 8 * S5_WLDS, S5_GP = 264;
__device__ __forceinline__ void s5_out_phase(const Frame& F, int layer) {
    unsigned char* ws = F.ws;
    LAS float* us = (LAS float*)(F.lds + F.wave * S5_WLDS);
    LAS float* hs = us + 1024;
    LAS bf16* G = (LAS bf16*)(F.lds + S5_GOFF);
    const int lane = F.lane, n = lane, c16 = lane & 15, kq = lane >> 4;
    for (int unit = F.vcu; unit < NB * NCH; unit += F.G) {
        const int b = unit / NCH, k = unit - b * NCH;
        for (int gi = 0; gi < 2; ++gi) {
            const int g = 2 * F.wave + gi;
            const float* tb = (const float*)(ws + WS_S5T) + (size_t)(layer * NG + g) * 2304;
            const float ar = tb[n], ai = tb[64 + n], lr = tb[128 + n], li = tb[192 + n];
            f32x4 br[4], bi[4];
#pragma unroll
            for (int j = 0; j < 4; ++j) { br[j] = *(const f32x4*)(tb + 256 + n * 16 + 4 * j); bi[j] = *(const f32x4*)(tb + 1280 + n * 16 + 4 * j); }
            float hr = 0.f, hi = 0.f;
            const f32x2* se = (const f32x2*)(ws + WS_SEND) + (size_t)(b * NG + g) * NCH * 64 + n;
            for (int kk = 0; kk < k; kk += 16) {
                f32x2 sv[16];
#pragma unroll
                for (int j = 0; j < 16; ++j) { const int ki = (kk + j < k) ? kk + j : k - 1; sv[j] = *(const GAS f32x2*)(se + (size_t)ki * 64); }
#pragma unroll
                for (int j = 0; j < 16; ++j) if (kk + j < k) { const float nr = lr * hr - li * hi + sv[j].x, ni = lr * hi + li * hr + sv[j].y; hr = nr; hi = ni; }
            }
            const float* cre = F.in[IN_C_RE] + ((size_t)(layer * NG + g) * SG + c16) * NS; const float* cim = F.in[IN_C_IM] + ((size_t)(layer * NG + g) * SG + c16) * NS;
            float cm[32];
#pragma unroll
            for (int ks = 0; ks < 16; ++ks) { cm[ks] = cre[4 * ks + kq]; cm[16 + ks] = -cim[4 * ks + kq]; }
            const float dsk = F.in[IN_SSM_D][layer * SSMW + 16 * g + c16];
            const float* up = (const float*)(ws + WS_SU) + ((size_t)b * SEQ + 64 * k + lane) * SSMW + 16 * g;
#pragma unroll
            for (int j = 0; j < 4; ++j) *(LAS f32x4*)(us + lane * 16 + 4 * j) = *(const f32x4*)(up + 4 * j);
            LDS_WAIT();
            for (int sc = 0; sc < 4; ++sc) {
                for (int t = 0; t < 16; ++t) {
                    float sr = 0.f, si = 0.f;
#pragma unroll
                    for (int j = 0; j < 4; ++j) { const f32x4 u = *(const LAS f32x4*)(us + (16 * sc + t) * 16 + 4 * j);
                        sr += (br[j][0] * u[0] + br[j][1] * u[1]) + (br[j][2] * u[2] + br[j][3] * u[3]); si += (bi[j][0] * u[0] + bi[j][1] * u[1]) + (bi[j][2] * u[2] + bi[j][3] * u[3]); }
                    const float nr = ar * hr - ai * hi + sr, ni = ar * hi + ai * hr + si; hr = nr; hi = ni;
                    hs[t * S5_HS + n] = hr; hs[t * S5_HS + 64 + n] = hi;
                }
                LDS_WAIT();
                f32x4 y = {0.f, 0.f, 0.f, 0.f};
#pragma unroll
                for (int ks = 0; ks < 32; ++ks) { const float a = hs[c16 * S5_HS + 4 * ks + kq]; y = __builtin_amdgcn_mfma_f32_16x16x4f32(a, cm[ks], y, 0, 0, 0); }
#pragma unroll
                for (int i = 0; i < 4; ++i) { const int tl = 16 * sc + 4 * kq + i; const float yy = y[i] + dsk * us[tl * 16 + c16]; G[tl * S5_GP + 16 * g + c16] = (bf16)f2bf(gelu_tanh(yy)); }
                LDS_WAIT();
            }
        }
        __syncthreads();
        {
            const bf16* Wt = (const bf16*)(ws + WS_WGLU) + (size_t)layer * 65536;
            f32x4 z[4][2];
#pragma unroll
            for (int rb = 0; rb < 4; ++rb)
#pragma unroll
                for (int cb = 0; cb < 2; ++cb) z[rb][cb] = (f32x4){0.f, 0.f, 0.f, 0.f};
#pragma unroll
            for (int ks = 0; ks < 8; ++ks) {
                bf16x8 bfr[2], afr[4];
#pragma unroll
                for (int cb = 0; cb < 2; ++cb) bfr[cb] = *(const bf16x8*)(Wt + (size_t)(32 * F.wave + 16 * cb + c16) * 256 + 32 * ks + 8 * kq);
#pragma unroll
                for (int rb = 0; rb < 4; ++rb) afr[rb] = *(const LAS bf16x8*)(G + (16 * rb + c16) * S5_GP + 32 * ks + 8 * kq);
#pragma unroll
                for (int rb = 0; rb < 4; ++rb)
#pragma unroll
                    for (int cb = 0; cb < 2; ++cb) z[rb][cb] = __builtin_amdgcn_mfma_f32_16x16x32_bf16(afr[rb], bfr[cb], z[rb][cb], 0, 0, 0);
            }
#pragma unroll
            for (int cb = 0; cb < 2; ++cb) {
                const int oc = 32 * F.wave + 16 * cb + c16;
                const float bg = F.in[IN_B_GLU][layer * SSMW + oc], on = F.in[IN_OUT_NORM][layer * DM + 768 + oc];
#pragma unroll
                for (int rb = 0; rb < 4; ++rb)
#pragma unroll
                    for (int i = 0; i < 4; ++i) {
                        const int tl = 16 * rb + 4 * kq + i;
                        const float gg = bf2f(G[tl * S5_GP + oc]);
                        const float v = gg * frcp(1.f + fexp2(-(z[rb][cb][i] + bg) * LOG2E));
                        float ss = v * v; ss += __shfl_xor(ss, 1); ss += __shfl_xor(ss, 2); ss += __shfl_xor(ss, 4); ss += __shfl_xor(ss, 8);
                        const float o = v * __builtin_amdgcn_rsqf(ss * (1.f / 16.f) + EPS) * on;
                        ((bf16*)(ws + WS_MIX))[((size_t)b * SEQ + 64 * k + tl) * DM + 768 + oc] = (bf16)f2bf(o);
                    }
            }
        }
        __syncthreads();
    }
}

#ifndef PHM
#define PHM 0xffff
#endif
__device__ __forceinline__ Frame make_frame(unsigned char* ws_in, LAS unsigned char* lds) {
    Frame F; unsigned char* ws = ws_in; asm volatile("" : "+s"(ws));
    int tid = threadIdx.x; asm volatile("" : "+v"(tid));
    F.lds = lds; F.tid = tid; F.lane = tid & 63; F.wave = __builtin_amdgcn_readfirstlane(tid >> 6);
    F.G = gridDim.x; { const int bx = blockIdx.x; F.vcu = (bx % 8) * (F.G / 8) + bx / 8; }
    F.ws = ws; F.ctl = (gu32*)(ws + WS_CTL); F.in = (const float* const*)(ws + WS_PTRS); F.out = nullptr;
    return F;
}
__global__ void __launch_bounds__(512, 2) hybrid_fwd(Args args) {
    extern __shared__ __attribute__((aligned(16))) unsigned char lds_raw[];
    LAS unsigned char* const lds = (LAS unsigned char*)lds_raw;
    for (int u = threadIdx.x; u < (LDS_BYTES - LDS_CTL) / 4; u += 512) ((LAS unsigned*)(lds + LDS_CTL))[u] = 0u;
    __syncthreads();
    XcdBarrier bar = xcd_barrier_post((unsigned*)(args.ws + WS_CTL) + CW_BAR + args.li * XCD_BAR_WORDS, (volatile LAS unsigned*)(lds + LDS_CTL) + 8);
    const int lo = args.ph_lo, hi = args.ph_hi;
    int ph = 0;
#define PH_BEGIN if (ph >= lo && ph < hi) { Frame F = make_frame(args.ws, lds); unsigned char* const ws = F.ws; (void)ws; int layer = layer_; asm volatile("" : "+s"(layer)); const bool moe = (layer & 1) != 0; const int j2 = layer >> 1; (void)moe; (void)j2;
#define PH_END   if (ph + 1 < hi) xcd_barrier(bar); } ++ph;
    const size_t TS1 = (size_t)256 * DM * 2, TS3 = (size_t)256 * DFF * 2;

    { const int layer_ = 0; PH_BEGIN F.out = args.out; if (PHM & 1) p0_prologue(F, args); PH_END }

    for (int layer_ = 0; layer_ < NL; ++layer_) {
        PH_BEGIN F.out = (float*)F.in[26]; if (PHM & 2) norm_phase<0>(F, layer, layer > 0 && ((layer - 1) & 1), (layer == 0) ? F.in[IN_X] : F.out); PH_END
        PH_BEGIN
            if (PHM & 4) cumsum_phase(F);
            __syncthreads();
            { const pg8::SchedLds S = pg8::build_units_plain(F.lds, F.tid, F.G, (int)blockIdx.x, T / 256, NQK / 256, (const char*)(ws + WS_XN), (const char*)(ws + WS_WIN) + (size_t)layer * 2560 * DM * 2, TS1);
              pg8::EpiProj E{(bf16*)(ws + WS_FQ), (bf16*)(ws + WS_FK), (bf16*)(ws + WS_SQ), (bf16*)(ws + WS_SK), (float*)(ws + WS_SU), F.in[IN_FQN] + layer * 64, F.in[IN_FKN] + layer * 64};
              if (PHM & 8) pg8::gemm_phase<pg8::EpiProj, pg8::SchedLds, true, true>(F.lds, F.tid, DM, S, E); }
            { const pg8::SchedLds S = pg8::build_units_plain(F.lds, F.tid, F.G, (int)blockIdx.x, NVT / 256, T / 256, (const char*)(ws + WS_WIN) + ((size_t)layer * 2560 + NQK) * DM * 2, (const char*)(ws + WS_XN), TS1);
              pg8::EpiStoreBf16 E{(bf16*)(ws + WS_VT), T, 0};
              if (PHM & 16) pg8::gemm_phase<pg8::EpiStoreBf16, pg8::SchedLds, true, true>(F.lds, F.tid, DM, S, E); }
        PH_END
        PH_BEGIN if (PHM & 32) attn_phase(F, layer); PH_END
        PH_BEGIN if (PHM & 64) s5_out_phase(F, layer); PH_END
        PH_BEGIN
            { float* const outp = (float*)F.in[26];
              const pg8::SchedLds S = pg8::build_units_plain(F.lds, F.tid, F.G, (int)blockIdx.x, T / 256, DM / 256, (const char*)(ws + WS_MIX), (const char*)(ws + WS_WOUT) + (size_t)layer * DM * DM * 2, TS1);
              pg8::EpiResid E{(layer == 0) ? F.in[IN_X] : (const float*)outp, outp};
              if (PHM & 128) pg8::gemm_phase<pg8::EpiResid, pg8::SchedLds, true, true>(F.lds, F.tid, DM, S, E); }
        PH_END
        if (!(layer_ & 1)) {
            PH_BEGIN F.out = (float*)F.in[26]; if (PHM & 256) norm_phase<1>(F, layer, false, F.out); PH_END
            PH_BEGIN
                { const pg8::SchedLds S = pg8::build_units_plain(F.lds, F.tid, F.G, (int)blockIdx.x, T / 256, 28, (const char*)(ws + WS_XN), (const char*)(ws + WS_DGU) + (size_t)j2 * 7168 * DM * 2, TS1);
                  pg8::EpiSwiglu E{(bf16*)(ws + WS_HID), 0};
                  if (PHM & 512) pg8::gemm_phase<pg8::EpiSwiglu, pg8::SchedLds, true, true>(F.lds, F.tid, DM, S, E); }
            PH_END
            PH_BEGIN
                { float* const outp = (float*)F.in[26];
                  const pg8::SchedLds S = pg8::build_units_plain(F.lds, F.tid, F.G, (int)blockIdx.x, T / 256, DM / 256, (const char*)(ws + WS_HID), (const char*)(ws + WS_DDN) + (size_t)j2 * DM * DFF * 2, TS3);
                  pg8::EpiResid E{outp, outp};
                  if (PHM & 1024) pg8::gemm_phase<pg8::EpiResid, pg8::SchedLds, true, true>(F.lds, F.tid, DFF, S, E); }
            PH_END
        } else {
            PH_BEGIN F.out = (float*)F.in[26]; if (PHM & 2048) norm_phase<2>(F, layer, false, F.out); PH_END
            PH_BEGIN if (PHM & 4096) moe_gather_phase(F); PH_END
            for (int pass_ = 0; pass_ < 2; ++pass_) {
                PH_BEGIN int pass = pass_; asm volatile("" : "+s"(pass));
                    { const int* mb = (const int*)(ws + WS_MOEB); const int ntl = mb[8]; const int tlo = pass * MOE_PASS_TILES; int nM = ntl - tlo; nM = nM < 0 ? 0 : (nM > MOE_PASS_TILES ? MOE_PASS_TILES : nM);
                      const pg8::SchedLds S = pg8::build_units_moe(F.lds, F.tid, F.G, (int)blockIdx.x, nM, 28, tlo, mb, (const char*)(ws + WS_R2), (const char*)(ws + WS_MGU) + (size_t)j2 * 8 * 7168 * DM * 2, TS1, TS1, (size_t)7168 * DM * 2, false);
                      pg8::EpiSwiglu E{(bf16*)(ws + WS_HID), tlo};
                      if (PHM & 8192) pg8::gemm_phase<pg8::EpiSwiglu, pg8::SchedLds, true, true>(F.lds, F.tid, DM, S, E); }
                PH_END
                PH_BEGIN int pass = pass_; asm volatile("" : "+s"(pass));
                    { const int* mb = (const int*)(ws + WS_MOEB); const int ntl = mb[8]; const int tlo = pass * MOE_PASS_TILES; int nM = ntl - tlo; nM = nM < 0 ? 0 : (nM > MOE_PASS_TILES ? MOE_PASS_TILES : nM);
                      const pg8::SchedLds S = pg8::build_units_moe(F.lds, F.tid, F.G, (int)blockIdx.x, nM, DM / 256, tlo, mb, (const char*)(ws + WS_HID), (const char*)(ws + WS_MDN) + (size_t)j2 * 8 * DM * DFF * 2, TS3, TS3, (size_t)DM * DFF * 2, true);
                      pg8::EpiStoreBf16 E{(bf16*)(ws + WS_R2), DM, 0};
                      if (PHM & 16384) pg8::gemm_phase<pg8::EpiStoreBf16, pg8::SchedLds, true, true>(F.lds, F.tid, DFF, S, E); }
                PH_END
            }
        }
    }
    { const int layer_ = NL; PH_BEGIN F.out = (float*)F.in[26]; if (PHM & 32768) norm_phase<3>(F, NL, true, F.out); PH_END }
#undef PH_BEGIN
#undef PH_END
}

#ifndef MK_SPLIT
#define MK_SPLIT 0
#endif
extern "C" void kernel_launch(void* const* d_in, const int* in_sizes, int n_in, void* d_out, int out_size, void* d_ws, size_t ws_size, hipStream_t stream) {
    static int grid = 0;
    if (grid == 0) {
        if (n_in != 26 || in_sizes[0] != T * DM || out_size != T * DM || ws_size < WS_END) {
            fprintf(stderr, "kernel_launch: unexpected problem (n_in %d, in0 %d, out %d, ws %zu < %zu); nothing launched\n", n_in, n_in > 0 ? in_sizes[0] : -1, out_size, ws_size, (size_t)WS_END); grid = -1; return; }
        int dev = 0, cus = 0, per_cu = 0;
        if (hipGetDevice(&dev) != hipSuccess || hipDeviceGetAttribute(&cus, hipDeviceAttributeMultiprocessorCount, dev) != hipSuccess) { grid = -1; return; }
        if (hipFuncSetAttribute((const void*)hybrid_fwd, hipFuncAttributeMaxDynamicSharedMemorySize, LDS_BYTES) != hipSuccess) { fprintf(stderr, "kernel_launch: hipFuncSetAttribute failed\n"); grid = -1; return; }
        if (hipOccupancyMaxActiveBlocksPerMultiprocessor(&per_cu, (const void*)hybrid_fwd, 512, LDS_BYTES) != hipSuccess || per_cu < 1) { fprintf(stderr, "kernel_launch: occupancy query says %d\n", per_cu); }
        (void)hipGetLastError();
        if (cus != 256) { fprintf(stderr, "kernel_launch: built for 256 CUs, device has %d; nothing launched\n", cus); grid = -1; return; }
        grid = 256;
    }
    if (grid < 0) return;
    if (hipMemsetAsync((char*)d_ws + WS_CTL, 0, CTL_BYTES, stream) != hipSuccess) return;
    Args a{};
    for (int i = 0; i < 26; ++i) a.in[i] = (const float*)d_in[i];
    a.out = (float*)d_out; a.ws = (unsigned char*)d_ws; a.pad = 0;
    constexpr int NPHASE = 64;
    if (MK_SPLIT == 0) { a.ph_lo = 0; a.ph_hi = NPHASE; a.li = 0; hipLaunchKernelGGL(hybrid_fwd, dim3(grid), dim3(512), LDS_BYTES, stream, a); }
    else { int li = 0; for (int p = 0; p < 48; p += MK_SPLIT, ++li) { a.ph_lo = p; a.ph_hi = p + MK_SPLIT; a.li = li; hipLaunchKernelGGL(hybrid_fwd, dim3(grid), dim3(512), LDS_BYTES, stream, a); } }
}
```
